# Optimizing an MI355X kernel written in HIP

```python
import math
import jax, jax.numpy as jnp
from jax import lax
import numpy as np

D_MODEL = 1024
BATCH = 8
SEQ = 4096
DEPTH = 2

CHUNK = 128
GMLP_WIDTH = D_MODEL
GMLP_GROUPS = 8
GMLP_GROUP_DIM = GMLP_WIDTH // GMLP_GROUPS
DA_HEAD_DIM = 64
DA_HEADS = D_MODEL // (2 * DA_HEAD_DIM)
DA_VALUE_WIDTH = DA_HEADS * 2 * DA_HEAD_DIM
Q_BLOCK = 128
REL_BUCKETS = 32
REL_MAX_DISTANCE = 128
D_FF = 2816
CONV_WIDTH = 3
EPS = 1e-6
IN_WIDTH = 2 * GMLP_WIDTH + 2 * (DA_HEADS * 2 * DA_HEAD_DIM) + DA_VALUE_WIDTH

kernel_name = "hybrid_gmlp_diffattn_convglu"


def rms_norm(x, g):
    xf = x.astype(jnp.float32)
    y = xf * lax.rsqrt(jnp.mean(xf * xf, axis=-1, keepdims=True) + EPS)
    return (y * g.astype(jnp.float32)).astype(x.dtype)


def t5_causal_bucket(rel):
    n = jnp.maximum(rel, 0)
    max_exact = REL_BUCKETS // 2
    nf = jnp.maximum(n, 1).astype(jnp.float32)
    large = max_exact + (jnp.log(nf / max_exact) / math.log(REL_MAX_DISTANCE / max_exact)
                         * (REL_BUCKETS - max_exact)).astype(jnp.int32)
    large = jnp.minimum(large, REL_BUCKETS - 1)
    return jnp.where(n < max_exact, n, large)


def gmlp_spatial_gate(u, v, v_norm_g, w_s, b_s):
    B, S, _ = v.shape
    nc = S // CHUNK
    v = rms_norm(v, v_norm_g)
    vc = v.reshape(B, nc, CHUNK, GMLP_GROUPS, GMLP_GROUP_DIM)
    causal = jnp.tril(jnp.ones((CHUNK, CHUNK), dtype=w_s.dtype))
    w_m = w_s * causal[None]
    mixed = jnp.einsum('gij,bnjgc->bnigc', w_m, vc) + b_s.T[None, None, :, :, None]
    return u * mixed.reshape(B, S, GMLP_WIDTH)


def diff_attention(q, k, v, lam, rel_bias):
    B, S = q.shape[0], q.shape[1]
    nb = S // Q_BLOCK
    scale = DA_HEAD_DIM ** -0.5
    k1 = k[:, :, :, 0].transpose(0, 2, 1, 3)
    k2 = k[:, :, :, 1].transpose(0, 2, 1, 3)
    vh = v.transpose(0, 2, 1, 3)
    qb = q.reshape(B, nb, Q_BLOCK, DA_HEADS, 2, DA_HEAD_DIM).transpose(1, 0, 3, 2, 4, 5)
    k_pos = jnp.arange(S)
    lam32 = lam.astype(jnp.float32)

    def block(args):
        i, qblk = args
        q_pos = i * Q_BLOCK + jnp.arange(Q_BLOCK)
        rel = q_pos[:, None] - k_pos[None, :]
        mask = rel >= 0
        bias = jnp.take(rel_bias, t5_causal_bucket(rel), axis=0)
        bias = bias.transpose(2, 0, 1).astype(jnp.float32)[None]
        s1 = jnp.einsum('bhqd,bhkd->bhqk', qblk[:, :, :, 0], k1).astype(jnp.float32) * scale + bias
        s2 = jnp.einsum('bhqd,bhkd->bhqk', qblk[:, :, :, 1], k2).astype(jnp.float32) * scale + bias
        a1 = jax.nn.softmax(jnp.where(mask, s1, -jnp.inf), axis=-1)
        a2 = jax.nn.softmax(jnp.where(mask, s2, -jnp.inf), axis=-1)
        a = (a1 - lam32 * a2).astype(vh.dtype)
        return jnp.einsum('bhqk,bhkc->bhqc', a, vh)

    out = lax.map(block, (jnp.arange(nb), qb))
    return out.transpose(1, 0, 3, 2, 4).reshape(B, S, DA_HEADS, 2 * DA_HEAD_DIM)


def causal_dwconv(a, w, b):
    S = a.shape[1]
    ap = jnp.pad(a, ((0, 0), (CONV_WIDTH - 1, 0), (0, 0)))
    out = b
    for j in range(CONV_WIDTH):
        out = out + w[j] * ap[:, j:j + S]
    return out


def setup_inputs(seed: int = 0) -> dict:
    key = jax.random.key(seed)
    ks = jax.random.split(key, 24)
    L = DEPTH

    def nrm(k, shape, scale):
        return jax.random.normal(k, shape, jnp.float32) * scale

    def gain(k, shape):
        return 1.0 + 0.02 * jax.random.normal(k, shape, jnp.float32)

    return {
        "x": jax.random.normal(ks[0], (BATCH, SEQ, D_MODEL), jnp.float32),
        "norm1_g": gain(ks[1], (L, D_MODEL)),
        "w_in": nrm(ks[2], (L, D_MODEL, IN_WIDTH), D_MODEL ** -0.5),
        "w_gate": nrm(ks[3], (L, D_MODEL, 2 * D_MODEL), D_MODEL ** -0.5),
        "gmlp_vnorm_g": gain(ks[4], (L, GMLP_WIDTH)),
        "gmlp_ws": nrm(ks[5], (L, GMLP_GROUPS, CHUNK, CHUNK), CHUNK ** -0.5),
        "gmlp_b": 1.0 + 0.02 * jax.random.normal(ks[6], (L, GMLP_GROUPS, CHUNK), jnp.float32),
        "lam_q1": nrm(ks[7], (L, DA_HEAD_DIM), 0.1),
        "lam_k1": nrm(ks[8], (L, DA_HEAD_DIM), 0.1),
        "lam_q2": nrm(ks[9], (L, DA_HEAD_DIM), 0.1),
        "lam_k2": nrm(ks[10], (L, DA_HEAD_DIM), 0.1),
        "subln_g": gain(ks[11], (L, 2 * DA_HEAD_DIM)),
        "rel_bias": nrm(ks[12], (REL_BUCKETS, DA_HEADS), 0.5),
        "w_a": nrm(ks[13], (L, GMLP_WIDTH, D_MODEL), GMLP_WIDTH ** -0.5),
        "w_b": nrm(ks[14], (L, DA_VALUE_WIDTH, D_MODEL), DA_VALUE_WIDTH ** -0.5),
        "w_out": nrm(ks[15], (L, D_MODEL, D_MODEL), D_MODEL ** -0.5),
        "norm2_g": gain(ks[16], (L, D_MODEL)),
        "w_up": nrm(ks[17], (L, D_MODEL, 2 * D_FF), D_MODEL ** -0.5),
        "conv_w": nrm(ks[18], (L, CONV_WIDTH, D_FF), CONV_WIDTH ** -0.5),
        "conv_b": nrm(ks[19], (L, D_FF), 0.02),
        "w_down": nrm(ks[20], (L, D_FF, D_MODEL), D_FF ** -0.5),
        "final_g": gain(ks[21], (D_MODEL,)),
    }


def reference(x, norm1_g, w_in, w_gate, gmlp_vnorm_g, gmlp_ws, gmlp_b, lam_q1, lam_k1,
              lam_q2, lam_k2, subln_g, rel_bias, w_a, w_b, w_out, norm2_g, w_up,
              conv_w, conv_b, w_down, final_g):
    B, S, _ = x.shape
    qk_w = DA_HEADS * 2 * DA_HEAD_DIM
    splits = np.cumsum([GMLP_WIDTH, GMLP_WIDTH, qk_w, qk_w]).tolist()
    for l in range(DEPTH):
        h = rms_norm(x, norm1_g[l])
        proj = jnp.einsum('bsd,de->bse', h, w_in[l])
        uv_u, uv_v, q, k, v = jnp.split(proj, splits, axis=-1)
        gates = jax.nn.sigmoid(jnp.einsum('bsd,de->bse', h, w_gate[l]))
        g_a, g_b = jnp.split(gates, 2, axis=-1)

        y_a = gmlp_spatial_gate(jax.nn.gelu(uv_u), jax.nn.gelu(uv_v),
                                gmlp_vnorm_g[l], gmlp_ws[l], gmlp_b[l])

        lam_init = 0.8 - 0.6 * math.exp(-0.3 * l)
        lam = (jnp.exp(jnp.sum(lam_q1[l].astype(jnp.float32) * lam_k1[l].astype(jnp.float32)))
               - jnp.exp(jnp.sum(lam_q2[l].astype(jnp.float32) * lam_k2[l].astype(jnp.float32)))
               + lam_init)
        q = q.reshape(B, S, DA_HEADS, 2, DA_HEAD_DIM)
        k = k.reshape(B, S, DA_HEADS, 2, DA_HEAD_DIM)
        v = v.reshape(B, S, DA_HEADS, 2 * DA_HEAD_DIM)
        o = diff_attention(q, k, v, lam, rel_bias)
        o = rms_norm(o, subln_g[l]) * (1.0 - lam_init)
        y_b = o.reshape(B, S, DA_VALUE_WIDTH)

        merged = (g_a * jnp.einsum('bsc,cd->bsd', y_a, w_a[l])
                  + g_b * jnp.einsum('bsc,cd->bsd', y_b, w_b[l]))
        x = x + jnp.einsum('bsd,de->bse', merged, w_out[l])

        h2 = rms_norm(x, norm2_g[l])
        up = jnp.einsum('bsd,df->bsf', h2, w_up[l])
        a, bval = jnp.split(up, 2, axis=-1)
        a = causal_dwconv(a, conv_w[l], conv_b[l])
        x = x + jnp.einsum('bsf,fd->bsd', jax.nn.gelu(a) * bval, w_down[l])
    return rms_norm(x, final_g)
```

```cpp
#include <hip/hip_runtime.h>
#include <hip/hip_cooperative_groups.h>
#include <hip/hip_bf16.h>
#include <cstdio>
#include <cstdint>
#include <cmath>
namespace cg = cooperative_groups;
#ifndef MK_SINGLE
#define MK_SINGLE 1
#endif
__device__ __forceinline__ int mk_tid() { int t = threadIdx.x; asm volatile("" : "+v"(t)); return t; }
namespace pg8 {
#define PG8_LAS __attribute__((address_space(3)))
typedef unsigned short bf16_t;
typedef short bf16x8 __attribute__((ext_vector_type(8)));
typedef float f32x4 __attribute__((ext_vector_type(4)));
typedef unsigned u32x4 __attribute__((ext_vector_type(4)));
constexpr int BM = 256, BK = 64, HALF = 128, HTB = HALF * BK * 2  , STAGE_BYTES = 8 * HTB, NXCD = 8, WGM = 8;

__host__ __device__ __forceinline__ int lds_byte(int r, int c) { const int st = (r >> 4) * 2 + (c >> 5), rr = r & 15, cc = c & 31, ob = rr * 64 + cc * 2; return st * 1024 + (ob ^ (((ob >> 9) & 1) << 5)); }
__host__ __device__ __forceinline__ void stage_rc(int b, int& R, int& C) { const int st = b / 1024, sb = b % 1024, swz = sb ^ (((sb >> 9) & 1) << 5); R = (st >> 1) * 16 + swz / 64; C = (st & 1) * 32 + (swz % 64) / 2; }
__host__ __device__ __forceinline__ int perm32(int rho) { const int n = rho >> 4, i = rho & 15; return 8 * (i >> 2) + 4 * n + (i & 3); }

struct Unit { int pm, pn; };
struct Gemm { const bf16_t* A; const bf16_t* Bt; int M, N, K; };

struct StaticOrder {
    int nM, nN, nwg, G, c;
    int amode;
    __host__ __device__ void init(int nM_, int nN_, int G_, int c_, int amode_ = 0) { nM = nM_; nN = nN_; nwg = nM * nN; G = G_; c = c_; amode = amode_; }
    __device__ __forceinline__ long a_byte(const Unit& u, int K) const { const long row = amode ? (long)((u.pm / 17) * 4096 + (u.pm % 17) * 254 - 2) : (long)u.pm * BM; return row * (long)K * 2; }
    __host__ __device__ bool next(int i, Unit& u) const {
        const long L = (long)i * G + c; if (L >= nwg) return false;
        int wgid = (int)L; { const int q = nwg / NXCD, r = nwg % NXCD, xcd = wgid % NXCD, off = wgid / NXCD; wgid = (xcd < r ? xcd * (q + 1) : r * (q + 1) + (xcd - r) * q) + off; }
        const int nig = WGM * nN, gid = wgid / nig, fm = gid * WGM, gsz = (nM - fm) < WGM ? (nM - fm) : WGM;
        u.pm = fm + ((wgid % nig) % gsz); u.pn = (wgid % nig) / gsz; return true;
    }
    __device__ __forceinline__ void a_ready(const Unit&) const {}
    __device__ __forceinline__ void done(const Unit&) const {}
};

typedef float f32x2_t __attribute__((ext_vector_type(2))); typedef __bf16 bf16x2_t __attribute__((ext_vector_type(2)));
__device__ __forceinline__ unsigned cvt_pk_bf16(float lo, float hi) { f32x2_t v = {lo, hi}; bf16x2_t b = __builtin_convertvector(v, bf16x2_t); return __builtin_bit_cast(unsigned, b); }
__device__ __forceinline__ float bf_lo(unsigned w) { return __uint_as_float(w << 16); }
__device__ __forceinline__ float bf_hi(unsigned w) { return __uint_as_float(w & 0xffff0000u); }
__device__ __forceinline__ float gelu_t(float x) {
    const float u = x * (0.7978845608f + 0.0356774081f * x * x);
    const float e = __builtin_amdgcn_exp2f(-2.8853900818f * u);
    return x * __builtin_amdgcn_rcpf(1.0f + e);
}
__device__ __forceinline__ float sigmoid_f(float x) { return __builtin_amdgcn_rcpf(1.0f + __builtin_amdgcn_exp2f(-1.4426950409f * x)); }
__device__ __forceinline__ u32x4 pack8(const f32x4& v0, const f32x4& v1) { u32x4 w; w.x = cvt_pk_bf16(v0[0], v0[1]); w.y = cvt_pk_bf16(v0[2], v0[3]); w.z = cvt_pk_bf16(v1[0], v1[1]); w.w = cvt_pk_bf16(v1[2], v1[3]); return w; }

__device__ __forceinline__ float row_rstd(const float* rss, long row, int fq) {
    const f32x4 p = *(const f32x4*)(rss + row * 16 + fq * 4); float s = (p[0] + p[1]) + (p[2] + p[3]); s += __shfl_xor(s, 16); s += __shfl_xor(s, 32);
    return rsqrtf(s * (1.0f / 1024.0f) + 1e-6f);
}
struct EpiIn {
    static constexpr bool PERM = true, AFTER_DRAIN = false;
    bf16_t* O0; size_t stride; bf16_t* O4; float* vss; float qscale; const float* rss;
    __device__ __forceinline__ void operator()(const f32x4 (&acc)[2][2][4][2], const Unit& u, int wr, int wc, int fr, int fq) const {
        const int t = u.pn >> 2, row0 = u.pm * BM + wr * 64 + fr, col0 = (u.pn & 3) * BM + wc * 32 + 8 * fq;
        bf16_t* base = (t == 4) ? O4 : O0 + (size_t)t * stride;
        const float sc = (t == 2) ? qscale : 1.f;
#pragma unroll
        for (int ai = 0; ai < 2; ++ai)
#pragma unroll
            for (int m = 0; m < 4; ++m) { const int row = row0 + ai * HALF + m * 16; bf16_t* rowp = base + (size_t)row * 1024 + col0; float ss = 0.f; const float rn = row_rstd(rss, row, fq);
#pragma unroll
                for (int bj = 0; bj < 2; ++bj) { f32x4 v0 = acc[ai][bj][m][0] * rn, v1 = acc[ai][bj][m][1] * rn;
                    if (t <= 1) {
#pragma unroll
                        for (int j = 0; j < 4; ++j) { v0[j] = gelu_t(v0[j]); v1[j] = gelu_t(v1[j]); }
#pragma unroll
                        for (int j = 0; j < 4; ++j) ss += v0[j] * v0[j] + v1[j] * v1[j];
                    }
                    v0 = v0 * sc; v1 = v1 * sc;
                    *(u32x4*)(rowp + bj * HALF) = pack8(v0, v1); }
                if (t == 1) { ss += __shfl_xor(ss, 16); ss += __shfl_xor(ss, 32); if (fq == 0) vss[(size_t)row * 16 + (u.pn & 3) * 4 + wc] = ss; } }
    }
};
struct EpiGate {
    static constexpr bool PERM = true, AFTER_DRAIN = false;
    bf16_t* GA; bf16_t* GB; const float* rss;
    __device__ __forceinline__ void operator()(const f32x4 (&acc)[2][2][4][2], const Unit& u, int wr, int wc, int fr, int fq) const {
        const int t = u.pn >> 2, row0 = u.pm * BM + wr * 64 + fr, col0 = (u.pn & 3) * BM + wc * 32 + 8 * fq;
        bf16_t* base = t ? GB : GA;
#pragma unroll
        for (int ai = 0; ai < 2; ++ai)
#pragma unroll
            for (int m = 0; m < 4; ++m) { bf16_t* rowp = base + (size_t)(row0 + ai * HALF + m * 16) * 1024 + col0; const float rn = row_rstd(rss, row0 + ai * HALF + m * 16, fq);
#pragma unroll
                for (int bj = 0; bj < 2; ++bj) { f32x4 v0 = acc[ai][bj][m][0] * rn, v1 = acc[ai][bj][m][1] * rn;
#pragma unroll
                    for (int j = 0; j < 4; ++j) { v0[j] = sigmoid_f(v0[j]); v1[j] = sigmoid_f(v1[j]); }
                    *(u32x4*)(rowp + bj * HALF) = pack8(v0, v1); } }
    }
};
template <int SECOND> struct EpiMerge {
    static constexpr bool PERM = true, AFTER_DRAIN = false;
    const bf16_t* G; bf16_t* T; bf16_t* MG;
    __device__ __forceinline__ void operator()(const f32x4 (&acc)[2][2][4][2], const Unit& u, int wr, int wc, int fr, int fq) const {
        const int row0 = u.pm * BM + wr * 64 + fr, col0 = u.pn * BM + wc * 32 + 8 * fq;
#pragma unroll
        for (int ai = 0; ai < 2; ++ai) {
            u32x4 gpre[4][2], tpre[4][2];
#pragma unroll
            for (int m = 0; m < 4; ++m)
#pragma unroll
                for (int bj = 0; bj < 2; ++bj) { const size_t off = (size_t)(row0 + ai * HALF + m * 16) * 1024 + col0 + bj * HALF; gpre[m][bj] = *(const u32x4*)(G + off); if (SECOND) tpre[m][bj] = *(const u32x4*)(T + off); }
#pragma unroll
            for (int m = 0; m < 4; ++m) { const size_t off = (size_t)(row0 + ai * HALF + m * 16) * 1024 + col0;
#pragma unroll
                for (int bj = 0; bj < 2; ++bj) { const u32x4 gw = gpre[m][bj];
                    f32x4 g0 = {bf_lo(gw.x), bf_hi(gw.x), bf_lo(gw.y), bf_hi(gw.y)}, g1 = {bf_lo(gw.z), bf_hi(gw.z), bf_lo(gw.w), bf_hi(gw.w)};
                    f32x4 v0 = acc[ai][bj][m][0] * g0, v1 = acc[ai][bj][m][1] * g1;
                    bf16_t* tp = T + off + bj * HALF;
                    if (SECOND) { const u32x4 tw = tpre[m][bj]; v0 += (f32x4){bf_lo(tw.x), bf_hi(tw.x), bf_lo(tw.y), bf_hi(tw.y)}; v1 += (f32x4){bf_lo(tw.z), bf_hi(tw.z), bf_lo(tw.w), bf_hi(tw.w)};
                        *(u32x4*)(MG + off + bj * HALF) = pack8(v0, v1); }
                    else { *(u32x4*)tp = pack8(v0, v1); } } }
        }
    }
};
struct EpiRes {
    static constexpr bool PERM = true, AFTER_DRAIN = false;
    const float* base; float* out; bf16_t* XG; const float* gn; float* rss;
    __device__ __forceinline__ void operator()(const f32x4 (&acc)[2][2][4][2], const Unit& u, int wr, int wc, int fr, int fq) const {
        const int row0 = u.pm * BM + wr * 64 + fr, col0 = u.pn * BM + wc * 32 + 8 * fq;
        f32x4 g0[2], g1[2];
        if (XG) {
#pragma unroll
            for (int bj = 0; bj < 2; ++bj) { g0[bj] = *(const f32x4*)(gn + col0 + bj * HALF); g1[bj] = *(const f32x4*)(gn + col0 + bj * HALF + 4); } }
#pragma unroll
        for (int ai = 0; ai < 2; ++ai) {
            f32x4 bpre[4][2][2];
#pragma unroll
            for (int m = 0; m < 4; ++m)
#pragma unroll
                for (int bj = 0; bj < 2; ++bj) { const float* bp = base + (size_t)(row0 + ai * HALF + m * 16) * 1024 + col0 + bj * HALF; bpre[m][bj][0] = *(const f32x4*)bp; bpre[m][bj][1] = *(const f32x4*)(bp + 4); }
#pragma unroll
            for (int m = 0; m < 4; ++m) { const int row = row0 + ai * HALF + m * 16; const size_t off = (size_t)row * 1024 + col0; float ss = 0.f;
#pragma unroll
                for (int bj = 0; bj < 2; ++bj) { float* op = out + off + bj * HALF;
                    const f32x4 x0 = bpre[m][bj][0] + acc[ai][bj][m][0], x1 = bpre[m][bj][1] + acc[ai][bj][m][1];
                    *(f32x4*)op = x0; *(f32x4*)(op + 4) = x1;
                    if (XG) { ss += ((x0[0] * x0[0] + x0[1] * x0[1]) + (x0[2] * x0[2] + x0[3] * x0[3])) + ((x1[0] * x1[0] + x1[1] * x1[1]) + (x1[2] * x1[2] + x1[3] * x1[3]));
                        *(u32x4*)(XG + off + bj * HALF) = pack8(x0 * g0[bj], x1 * g1[bj]); } }
                if (XG) { ss += __shfl_xor(ss, 16); ss += __shfl_xor(ss, 32); if (fq == 0) rss[(size_t)row * 16 + u.pn * 4 + wc] = ss; } }
        }
    }
};
__device__ __forceinline__ float dpp_ror1(float v) { return __int_as_float(__builtin_amdgcn_update_dpp(0, __float_as_int(v), 0x121, 0xf, 0xf, false)); }
__device__ __forceinline__ float dpp_ror2(float v) { return __int_as_float(__builtin_amdgcn_update_dpp(0, __float_as_int(v), 0x122, 0xf, 0xf, false)); }
struct EpiUp {
    static constexpr bool PERM = true, AFTER_DRAIN = false;
    bf16_t* ACT; const float* cw; const float* cb; PG8_LAS float* halo; const float* rss;
    __device__ __forceinline__ void operator()(const f32x4 (&acc)[2][2][4][2], const Unit& u, int wr, int wc, int fr, int fq) const {
        const int b = u.pm / 17, i = u.pm - b * 17, fl = wc * 32 + 8 * fq, f0 = u.pn * 128 + fl;
        float rn[2][4];
#pragma unroll
        for (int ai = 0; ai < 2; ++ai)
#pragma unroll
            for (int m = 0; m < 4; ++m) rn[ai][m] = row_rstd(rss, (long)b * 4096 + 254 * i - 2 + ai * HALF + wr * 64 + m * 16 + fr, fq);
        if (fr >= 14) {
#pragma unroll
            for (int ai = 0; ai < 2; ++ai)
#pragma unroll
                for (int n = 0; n < 2; ++n) *(PG8_LAS f32x4*)(halo + ((ai * 2 + wr) * 2 + (fr - 14)) * 128 + fl + 4 * n) = acc[ai][0][3][n] * rn[ai][3];
        }
        asm volatile("s_waitcnt lgkmcnt(0)" ::: "memory"); __builtin_amdgcn_s_barrier(); asm volatile("" ::: "memory");
        f32x4 w0[2], w1[2], w2[2], bb[2];
#pragma unroll
        for (int n = 0; n < 2; ++n) { w0[n] = *(const f32x4*)(cw + f0 + 4 * n); w1[n] = *(const f32x4*)(cw + 2816 + f0 + 4 * n); w2[n] = *(const f32x4*)(cw + 2 * 2816 + f0 + 4 * n); bb[n] = *(const f32x4*)(cb + f0 + 4 * n); }
#pragma unroll
        for (int ai = 0; ai < 2; ++ai) {
            const int blk = ai * 2 + wr;
            f32x4 pc1[2], pc2[2];
#pragma unroll
            for (int n = 0; n < 2; ++n) { f32x4 hv = {0.f, 0.f, 0.f, 0.f};
                if (blk > 0 && fr >= 14) hv = *(const PG8_LAS f32x4*)(halo + ((blk - 1) * 2 + (fr - 14)) * 128 + fl + 4 * n);
#pragma unroll
                for (int j = 0; j < 4; ++j) { pc1[n][j] = dpp_ror1(hv[j]); pc2[n][j] = dpp_ror2(hv[j]); } }
#pragma unroll
            for (int m = 0; m < 4; ++m) { const int r = ai * HALF + wr * 64 + m * 16 + fr, tk = 254 * i - 2 + r;
                f32x4 o[2];
#pragma unroll
                for (int n = 0; n < 2; ++n) { f32x4 cur = acc[ai][0][m][n] * rn[ai][m]; if (tk < 0) cur = (f32x4){0.f, 0.f, 0.f, 0.f};
#pragma unroll
                    for (int j = 0; j < 4; ++j) { const float c1 = dpp_ror1(cur[j]), c2 = dpp_ror2(cur[j]);
                        const float p1 = fr >= 1 ? c1 : pc1[n][j], p2 = fr >= 2 ? c2 : pc2[n][j]; pc1[n][j] = c1; pc2[n][j] = c2;
                        const float cv = bb[n][j] + w0[n][j] * p2 + w1[n][j] * p1 + w2[n][j] * cur[j];
                        o[n][j] = gelu_t(cv) * (acc[ai][1][m][n][j] * rn[ai][m]); } }
                if (r >= 2 && tk < 4096) *(u32x4*)(ACT + (size_t)(b * 4096 + tk) * 2816 + f0) = pack8(o[0], o[1]); }
        }
    }
};

template <class Epi, class Sched, bool ALIGN_EPI = false, bool SP2 = false>
__device__ __forceinline__ void gemm_phase(PG8_LAS unsigned char* lds, const Gemm g, const Sched& S, const Epi& E) {
    const int tid = mk_tid(), wid = __builtin_amdgcn_readfirstlane(tid >> 6), lane = tid & 63, wr = wid >> 2, wc = wid & 3, fr = lane & 15, fq = lane >> 4;
    const int K = g.K, nt = K / BK;
    unsigned voffA[2], voffB[2];
#pragma unroll
    for (int i = 0; i < 2; ++i) { int R, C; stage_rc(tid * 16 + i * 8192, R, C); const int Rb = Epi::PERM ? ((R & ~31) + perm32(R & 31)) : R;
        voffA[i] = (unsigned)(R * K + C) * 2u; voffB[i] = (unsigned)(Rb * K + C) * 2u; }
    const size_t kstep = (size_t)(BK * 2);
    const size_t hstep = (size_t)HALF * K * 2;
    const size_t tstep = 2 * hstep;
    const unsigned ldsw = (unsigned)wid * 1024u;
    const int aoff = lds_byte(wr * 64 + fr, fq * 8), boff = lds_byte(wc * 32 + fr, fq * 8);
#define PG8_SA(b, h) (((b) * 2 + (h)) * HTB)
#define PG8_SB(b, h) ((4 + (b) * 2 + (h)) * HTB)
#define PG8_STAGE(bufoff, gbase, voff) do { _Pragma("unroll") for (int _i = 0; _i < 2; ++_i) \
        __builtin_amdgcn_global_load_lds((const unsigned*)((const char*)(gbase) + (voff)[_i]), (PG8_LAS unsigned*)(lds + (bufoff) + ldsw + _i * 8192), 16, 0, 0); } while (0)
#define PG8_LDA(dst, b, h) do { _Pragma("unroll") for (int m = 0; m < 4; ++m) _Pragma("unroll") for (int k = 0; k < 2; ++k) dst[m][k] = *(const PG8_LAS bf16x8*)(lds + PG8_SA(b, h) + aoff + m * 2048 + k * 1024); } while (0)
#define PG8_LDB(dst, b, h) do { _Pragma("unroll") for (int n = 0; n < 2; ++n) _Pragma("unroll") for (int k = 0; k < 2; ++k) dst[n][k] = *(const PG8_LAS bf16x8*)(lds + PG8_SB(b, h) + boff + n * 2048 + k * 1024); } while (0)
#define PG8_MMA(ai, bj, At, Bt) do { __builtin_amdgcn_s_setprio(1); _Pragma("unroll") for (int m = 0; m < 4; ++m) _Pragma("unroll") for (int n = 0; n < 2; ++n) _Pragma("unroll") for (int k = 0; k < 2; ++k) \
        acc[ai][bj][m][n] = __builtin_amdgcn_mfma_f32_16x16x32_bf16(Bt[n][k], At[m][k], acc[ai][bj][m][n], 0, 0, 0); __builtin_amdgcn_s_setprio(0); } while (0)
#define PG8_WAIT_V(n) asm volatile("s_waitcnt vmcnt(" #n ")" ::: "memory")
#define PG8_WAIT_L(n) asm volatile("s_waitcnt lgkmcnt(" #n ")" ::: "memory")
#define PG8_BAR __builtin_amdgcn_s_barrier()
#define PG8_SCHED __builtin_amdgcn_sched_barrier(0)
    Unit cur, nxt; int ui = 0;
    if (!S.next(0, cur)) return;
    f32x4 acc[2][2][4][2];
#pragma unroll
    for (int a = 0; a < 2; ++a)
#pragma unroll
        for (int b = 0; b < 2; ++b)
#pragma unroll
            for (int m = 0; m < 4; ++m)
#pragma unroll
                for (int n = 0; n < 2; ++n) acc[a][b][m][n] = (f32x4){0.f, 0.f, 0.f, 0.f};
    bf16x8 At[4][2], B0[2][2], B1[2][2];
    const char* cA = (const char*)g.A + S.a_byte(cur, K); const char* cB = (const char*)g.Bt + (size_t)cur.pn * tstep;
    S.a_ready(cur);
    if constexpr (SP2) {
        PG8_STAGE(PG8_SB(0, 0), cB, voffB); PG8_STAGE(PG8_SB(0, 1), cB + hstep, voffB); PG8_STAGE(PG8_SA(0, 0), cA, voffA); PG8_STAGE(PG8_SA(0, 1), cA + hstep, voffA);
        if (wr == 1) PG8_BAR;
        PG8_WAIT_V(2); PG8_BAR;
        PG8_STAGE(PG8_SB(1, 0), cB + kstep, voffB); PG8_STAGE(PG8_SA(1, 0), cA + kstep, voffA); PG8_STAGE(PG8_SB(1, 1), cB + hstep + kstep, voffB);
        PG8_WAIT_V(6); PG8_BAR;
    } else {
        PG8_STAGE(PG8_SB(0, 0), cB, voffB); PG8_STAGE(PG8_SA(0, 0), cA, voffA); PG8_STAGE(PG8_SB(0, 1), cB + hstep, voffB); PG8_STAGE(PG8_SA(0, 1), cA + hstep, voffA);
        if (wr == 1) PG8_BAR;
        PG8_WAIT_V(4); PG8_BAR;
        PG8_STAGE(PG8_SB(1, 0), cB + kstep, voffB); PG8_STAGE(PG8_SA(1, 0), cA + kstep, voffA); PG8_STAGE(PG8_SB(1, 1), cB + hstep + kstep, voffB);
        PG8_WAIT_V(6); PG8_BAR;
    }
    for (;;) {
        const bool has_next = S.next(ui + 1, nxt);
        const char* nA = has_next ? (const char*)g.A + S.a_byte(nxt, K) : cA; const char* nB = has_next ? (const char*)g.Bt + (size_t)nxt.pn * tstep : cB;
        for (int t = 0; t < nt; t += 2) {
            const bool last = (t == nt - 2);
            const char* a1 = cA + (size_t)(t + 1) * kstep;
            const char* a2 = last ? nA : cA + (size_t)(t + 2) * kstep; const char* b2 = last ? nB : cB + (size_t)(t + 2) * kstep;
            const char* a3 = a2 + kstep; const char* b3 = b2 + kstep;
            if (last && has_next) S.a_ready(nxt);
            if constexpr (SP2) {
            PG8_LDB(B0, 0, 0); PG8_LDB(B1, 0, 1); PG8_SCHED; PG8_LDA(At, 0, 0); PG8_STAGE(PG8_SA(1, 1), a1 + hstep, voffA);
            PG8_WAIT_V(8); PG8_WAIT_L(0); PG8_BAR; PG8_MMA(0, 0, At, B0); PG8_MMA(0, 1, At, B1); PG8_BAR; PG8_SCHED;
            PG8_LDA(At, 0, 1); PG8_STAGE(PG8_SB(0, 0), b2, voffB); PG8_STAGE(PG8_SB(0, 1), b2 + hstep, voffB); PG8_STAGE(PG8_SA(0, 0), a2, voffA);
            PG8_WAIT_V(8); PG8_WAIT_L(0); PG8_BAR; PG8_MMA(1, 0, At, B0); PG8_MMA(1, 1, At, B1); PG8_BAR; PG8_SCHED;
            PG8_LDB(B0, 1, 0); PG8_LDB(B1, 1, 1); PG8_SCHED; PG8_LDA(At, 1, 0); PG8_STAGE(PG8_SA(0, 1), a2 + hstep, voffA);
            PG8_WAIT_V(8); PG8_WAIT_L(0); PG8_BAR; PG8_MMA(0, 0, At, B0); PG8_MMA(0, 1, At, B1); PG8_BAR; PG8_SCHED;
            PG8_LDA(At, 1, 1); PG8_STAGE(PG8_SB(1, 0), b3, voffB); PG8_STAGE(PG8_SB(1, 1), b3 + hstep, voffB); PG8_STAGE(PG8_SA(1, 0), a3, voffA);
            PG8_WAIT_V(8); PG8_WAIT_L(0); PG8_BAR; PG8_MMA(1, 0, At, B0); PG8_MMA(1, 1, At, B1); PG8_BAR; PG8_SCHED;
            } else {
            PG8_LDB(B0, 0, 0); PG8_SCHED; PG8_LDA(At, 0, 0); PG8_STAGE(PG8_SA(1, 1), a1 + hstep, voffA);
            PG8_WAIT_L(8); PG8_BAR; PG8_WAIT_L(0); PG8_MMA(0, 0, At, B0); PG8_BAR; PG8_SCHED;
            PG8_LDB(B1, 0, 1); PG8_STAGE(PG8_SB(0, 0), b2, voffB);
            PG8_BAR; PG8_WAIT_L(0); PG8_MMA(0, 1, At, B1); PG8_BAR;
            PG8_LDA(At, 0, 1); PG8_STAGE(PG8_SA(0, 0), a2, voffA);
            PG8_BAR; PG8_WAIT_L(0); PG8_MMA(1, 0, At, B0); PG8_BAR; PG8_SCHED;
            PG8_STAGE(PG8_SB(0, 1), b2 + hstep, voffB);
            PG8_WAIT_V(6); PG8_BAR; PG8_MMA(1, 1, At, B1); PG8_BAR;
            PG8_LDB(B0, 1, 0); PG8_SCHED; PG8_LDA(At, 1, 0); PG8_STAGE(PG8_SA(0, 1), a2 + hstep, voffA);
            PG8_WAIT_L(8); PG8_BAR; PG8_WAIT_L(0); PG8_MMA(0, 0, At, B0); PG8_BAR; PG8_SCHED;
            PG8_LDB(B1, 1, 1); PG8_STAGE(PG8_SB(1, 0), b3, voffB);
            PG8_BAR; PG8_WAIT_L(0); PG8_MMA(0, 1, At, B1); PG8_BAR;
            PG8_LDA(At, 1, 1); PG8_STAGE(PG8_SA(1, 0), a3, voffA);
            PG8_BAR; PG8_WAIT_L(0); PG8_MMA(1, 0, At, B0); PG8_BAR; PG8_SCHED;
            PG8_STAGE(PG8_SB(1, 1), b3 + hstep, voffB);
            PG8_WAIT_V(6); PG8_BAR; PG8_MMA(1, 1, At, B1); PG8_BAR;
            }
        }
        if constexpr (ALIGN_EPI) { if (wr == 0) PG8_BAR; }
        if constexpr (!Epi::AFTER_DRAIN) { E(acc, cur, wr, wc, fr, fq); S.done(cur); }
        if (!has_next) break;
#pragma unroll
        for (int a = 0; a < 2; ++a)
#pragma unroll
            for (int b = 0; b < 2; ++b)
#pragma unroll
                for (int m = 0; m < 4; ++m)
#pragma unroll
                    for (int n = 0; n < 2; ++n) acc[a][b][m][n] = (f32x4){0.f, 0.f, 0.f, 0.f};
        cur = nxt; cA = nA; cB = nB; ++ui;
        if constexpr (ALIGN_EPI) { if (wr == 1) PG8_BAR; }
    }
    PG8_WAIT_V(0);
    if constexpr (!ALIGN_EPI) { if (wr == 0) PG8_BAR; }
    PG8_BAR;
    if constexpr (Epi::AFTER_DRAIN) { E.fused(acc, cur, wr, wc, fr, fq, lds, wid, lane); S.done(cur); }
#undef PG8_SA
#undef PG8_SB
#undef PG8_STAGE
#undef PG8_LDA
#undef PG8_LDB
#undef PG8_MMA
#undef PG8_WAIT_V
#undef PG8_WAIT_L
#undef PG8_BAR
#undef PG8_SCHED
}
}

#define GAS __attribute__((address_space(1)))
#define LAS __attribute__((address_space(3)))
typedef unsigned short bf16;
typedef unsigned v4u __attribute__((ext_vector_type(4)));
typedef unsigned v2u __attribute__((ext_vector_type(2)));
typedef float f32x4 __attribute__((ext_vector_type(4)));
typedef short bf16x8 __attribute__((ext_vector_type(8)));
typedef float f32x16 __attribute__((ext_vector_type(16)));
#define LDS_WAIT() asm volatile("s_waitcnt lgkmcnt(0)" ::: "memory")
#define VM_WAIT() asm volatile("s_waitcnt vmcnt(0)" ::: "memory")
__device__ __forceinline__ unsigned f2bf(float f) { unsigned u = __builtin_bit_cast(unsigned, f); return (u + 0x7fffu + ((u >> 16) & 1u)) >> 16; }
__device__ __forceinline__ unsigned pk2(float lo, float hi) { return f2bf(lo) | (f2bf(hi) << 16); }
__device__ __forceinline__ float bflo(unsigned w) { return __uint_as_float(w << 16); }
__device__ __forceinline__ float bfhi(unsigned w) { return __uint_as_float(w & 0xffff0000u); }

constexpr int NWAVES = 8;
constexpr int BATCH = 8, SEQ = 4096, DM = 1024, M = BATCH * SEQ, NIN = 5120, NGATE = 2048, DFF = 2816, NUP = 2 * DFF, DEPTH = 2, NHEAD = 8;
constexpr float EPS = 1e-6f;
constexpr float QSCALE = 0.125f * 1.4426950408889634f;
constexpr size_t MiB = 1u << 20;
constexpr size_t WS_LAM = 0, WS_TAB = 4096, WS_VSS = 1 * MiB;
constexpr size_t WS_W = 4 * MiB, WL_STRIDE = 38273024;
constexpr size_t WO_IN = 0, WO_G = 10 * MiB, WO_A = 14 * MiB, WO_B = 16 * MiB, WO_O = 18 * MiB, WO_UP = 20 * MiB, WO_DN = 31 * MiB;
constexpr size_t WS_RSS = 78 * MiB;
constexpr size_t WS_HB = 112 * MiB, WS_VA = 176 * MiB, WS_U = 240 * MiB, WS_V = 304 * MiB, WS_Q = 368 * MiB, WS_K = 432 * MiB;
constexpr size_t WS_TMP = WS_HB;
constexpr size_t WS_YA = WS_U, WS_MG = WS_U, WS_GA = WS_V, WS_YB = WS_Q, WS_GB = WS_K;
constexpr size_t WS_ACT = WS_U;
constexpr size_t WS_END = 496 * MiB;
constexpr int RING_BYTES = 131072, HALO_OFF = RING_BYTES + 1024, LDS_BYTES = 147456;

__device__ __forceinline__ float wave_sum(float v) {
#pragma unroll
    for (int o = 1; o < 64; o <<= 1) v += __shfl_xor(v, o);
    return v;
}
__device__ __forceinline__ void transpose_item(const float* W, int K, int N, bf16* WT, bool upmap, LAS float* scr, int item, int lane) {
    const int nblk = N / 32, kb = item / nblk, nb = item % nblk, k0 = 64 * kb, n0 = 32 * nb;
    int d0 = n0;
    if (upmap) { const int f = n0 < DFF ? n0 : n0 - DFF; d0 = (f >> 7) * 256 + (f & 127) + (n0 < DFF ? 0 : 128); }
#pragma unroll 8
    for (int i = 0; i < 32; ++i) { const int kk = 2 * i + (lane >> 5); scr[kk * 33 + (lane & 31)] = W[(size_t)(k0 + kk) * N + n0 + (lane & 31)]; }
    LDS_WAIT(); asm volatile("" ::: "memory");
    const int c = lane & 7;
#pragma unroll
    for (int j = 0; j < 4; ++j) { const int n = (lane >> 3) + 8 * j; const LAS float* s = scr + (8 * c) * 33 + n;
        v4u o; o.x = pk2(s[0 * 33], s[1 * 33]); o.y = pk2(s[2 * 33], s[3 * 33]); o.z = pk2(s[4 * 33], s[5 * 33]); o.w = pk2(s[6 * 33], s[7 * 33]);
        *(GAS v4u*)(WT + (size_t)(d0 + n) * K + k0 + 8 * c) = o; }
    LDS_WAIT(); asm volatile("" ::: "memory");
}
__device__ __forceinline__ void norm_row_bf16(const float* xrow, const float* g, bf16* orow, int lane) {
    const f32x4* xr = (const f32x4*)xrow + lane; const f32x4* gr = (const f32x4*)g + lane;
    f32x4 v[4]; float s2 = 0.f;
#pragma unroll
    for (int j = 0; j < 4; ++j) { v[j] = xr[64 * j]; s2 += (v[j].x * v[j].x + v[j].y * v[j].y) + (v[j].z * v[j].z + v[j].w * v[j].w); }
    const float rstd = rsqrtf(wave_sum(s2) * (1.f / DM) + EPS);
    v2u* o8 = (v2u*)orow + lane;
#pragma unroll
    for (int j = 0; j < 4; ++j) { const f32x4 gg = gr[64 * j]; v2u w; w.x = pk2(v[j].x * rstd * gg.x, v[j].y * rstd * gg.y); w.y = pk2(v[j].z * rstd * gg.z, v[j].w * rstd * gg.w); o8[64 * j] = w; }
}
__device__ __forceinline__ void norm_row_f32(float* xrow, const float* g, int lane) {
    f32x4* xr = (f32x4*)xrow + lane; const f32x4* gr = (const f32x4*)g + lane;
    f32x4 v[4]; float s2 = 0.f;
#pragma unroll
    for (int j = 0; j < 4; ++j) { v[j] = xr[64 * j]; s2 += (v[j].x * v[j].x + v[j].y * v[j].y) + (v[j].z * v[j].z + v[j].w * v[j].w); }
    const float rstd = rsqrtf(wave_sum(s2) * (1.f / DM) + EPS);
#pragma unroll
    for (int j = 0; j < 4; ++j) xr[64 * j] = v[j] * rstd * gr[64 * j];
}
__device__ __forceinline__ void norm_rows4_bf16(const float* x, const float* g, bf16* o, size_t m, size_t rs, int lane) {
    f32x4 v[4][4]; float s2[4];
#pragma unroll
    for (int r = 0; r < 4; ++r) { const f32x4* xr = (const f32x4*)(x + (m + r * rs) * DM) + lane;
#pragma unroll
        for (int j = 0; j < 4; ++j) v[r][j] = xr[64 * j]; }
    const f32x4* gr = (const f32x4*)g + lane; f32x4 gg[4];
#pragma unroll
    for (int j = 0; j < 4; ++j) gg[j] = gr[64 * j];
#pragma unroll
    for (int r = 0; r < 4; ++r) { s2[r] = 0.f;
#pragma unroll
        for (int j = 0; j < 4; ++j) s2[r] += (v[r][j].x * v[r][j].x + v[r][j].y * v[r][j].y) + (v[r][j].z * v[r][j].z + v[r][j].w * v[r][j].w); }
#pragma unroll
    for (int r = 0; r < 4; ++r) { const float rstd = rsqrtf(wave_sum(s2[r]) * (1.f / DM) + EPS); v2u* o8 = (v2u*)(o + (m + r * rs) * DM) + lane;
#pragma unroll
        for (int j = 0; j < 4; ++j) { v2u w; w.x = pk2(v[r][j].x * rstd * gg[j].x, v[r][j].y * rstd * gg[j].y); w.y = pk2(v[r][j].z * rstd * gg[j].z, v[r][j].w * rstd * gg[j].w); o8[64 * j] = w; } }
}
__device__ __forceinline__ void norm_rows4_f32(float* x, const float* g, size_t m, size_t rs, int lane) {
    f32x4 v[4][4]; float s2[4];
#pragma unroll
    for (int r = 0; r < 4; ++r) { const f32x4* xr = (const f32x4*)(x + (m + r * rs) * DM) + lane;
#pragma unroll
        for (int j = 0; j < 4; ++j) v[r][j] = xr[64 * j]; }
    const f32x4* gr = (const f32x4*)g + lane; f32x4 gg[4];
#pragma unroll
    for (int j = 0; j < 4; ++j) gg[j] = gr[64 * j];
#pragma unroll
    for (int r = 0; r < 4; ++r) { s2[r] = 0.f;
#pragma unroll
        for (int j = 0; j < 4; ++j) s2[r] += (v[r][j].x * v[r][j].x + v[r][j].y * v[r][j].y) + (v[r][j].z * v[r][j].z + v[r][j].w * v[r][j].w); }
#pragma unroll
    for (int r = 0; r < 4; ++r) { const float rstd = rsqrtf(wave_sum(s2[r]) * (1.f / DM) + EPS); f32x4* xr = (f32x4*)(x + (m + r * rs) * DM) + lane;
#pragma unroll
        for (int j = 0; j < 4; ++j) xr[64 * j] = v[r][j] * rstd * gg[j]; }
}
__device__ __forceinline__ void gain_rows4_bf16(const float* x, const float* g, bf16* o, float* rss, size_t m, size_t rs, int lane) {
    f32x4 v[4][4];
#pragma unroll
    for (int r = 0; r < 4; ++r) { const f32x4* xr = (const f32x4*)(x + (m + r * rs) * DM) + lane;
#pragma unroll
        for (int j = 0; j < 4; ++j) v[r][j] = xr[64 * j]; }
    const f32x4* gr = (const f32x4*)g + lane; f32x4 gg[4];
#pragma unroll
    for (int j = 0; j < 4; ++j) gg[j] = gr[64 * j];
#pragma unroll
    for (int r = 0; r < 4; ++r) { float s2 = 0.f; v2u* o8 = (v2u*)(o + (m + r * rs) * DM) + lane;
#pragma unroll
        for (int j = 0; j < 4; ++j) { s2 += (v[r][j].x * v[r][j].x + v[r][j].y * v[r][j].y) + (v[r][j].z * v[r][j].z + v[r][j].w * v[r][j].w);
            v2u w; w.x = pk2(v[r][j].x * gg[j].x, v[r][j].y * gg[j].y); w.y = pk2(v[r][j].z * gg[j].z, v[r][j].w * gg[j].w); o8[64 * j] = w; }
        s2 = wave_sum(s2); if (lane < 16) rss[(m + r * rs) * 16 + lane] = lane == 0 ? s2 : 0.f; }
}
__device__ __forceinline__ int t5_bucket(int n) {
    if (n < 16) return n;
    int b = 15;
    b += (n >= 16) + (n >= 19) + (n >= 21) + (n >= 24) + (n >= 27) + (n >= 31) + (n >= 35) + (n >= 40) + (n >= 46) + (n >= 52) + (n >= 59) + (n >= 67) + (n >= 77) + (n >= 87) + (n >= 99) + (n >= 113);
    return b;
}
__device__ __forceinline__ int crow16(int r, int hi) { return (r & 3) + 8 * (r >> 2) + 4 * hi; }
__device__ __forceinline__ void gmlp_phase(LAS unsigned char* lds, int vcu, int G, const bf16* V, bf16* U, const float* vss, const float* gv, const float* wsl, const float* bl, int tid) {
    LAS bf16* WmS = (LAS bf16*)lds;
    LAS bf16* VnT = (LAS bf16*)(lds + 34816);
    const int lane = tid & 63, w = tid >> 6, ib = w >> 1, cb = w & 1, r32 = lane & 31, hi = lane >> 5, j = tid & 127, cq = tid >> 7;
    if (vcu >= 2048) return;
    v4u vraw[4]; f32x4 pa, pb, pc, pd; unsigned short ur0[16], ur1[16];
#define GM_LOAD(UU) do { const int m0_ = ((UU) >> 3) * 128, g_ = (UU) & 7; const bf16* src_ = V + (size_t)(m0_ + j) * 1024 + g_ * 128 + cq * 32; \
        _Pragma("unroll") for (int q = 0; q < 4; ++q) vraw[q] = *(const v4u*)(src_ + q * 8); \
        const f32x4* pp_ = (const f32x4*)(vss + (size_t)(m0_ + j) * 16); pa = pp_[0]; pb = pp_[1]; pc = pp_[2]; pd = pp_[3]; \
        _Pragma("unroll") for (int r = 0; r < 16; ++r) { const bf16* up_ = U + (size_t)(m0_ + 32 * ib + crow16(r, hi)) * 1024 + g_ * 128 + 64 * cb + r32; ur0[r] = up_[0]; ur1[r] = up_[32]; } } while (0)
    GM_LOAD(vcu);
    int g_cur = -1; f32x4 gq[8]; float bi[16];
    for (int u = vcu; u < 2048; u += G) {
        const int m0 = (u >> 3) * 128, g = u & 7;
        if (g != g_cur) {
            g_cur = g; const float* wsg = wsl + g * 128 * 128; const float* gp = gv + g * 128 + cq * 32;
#pragma unroll
            for (int k = 0; k < 8; ++k) { const int p = tid + 512 * k, i = p >> 5, j4 = (p & 31) * 4; f32x4 x = *(const f32x4*)(wsg + i * 128 + j4);
                if (j4 + 0 > i) x.x = 0.f; if (j4 + 1 > i) x.y = 0.f; if (j4 + 2 > i) x.z = 0.f; if (j4 + 3 > i) x.w = 0.f;
                v2u o; o.x = pk2(x.x, x.y); o.y = pk2(x.z, x.w); *(LAS v2u*)(WmS + i * 136 + j4) = o; }
#pragma unroll
            for (int q = 0; q < 8; ++q) gq[q] = *(const f32x4*)(gp + q * 4);
#pragma unroll
            for (int r = 0; r < 16; ++r) bi[r] = bl[g * 128 + 32 * ib + crow16(r, hi)];
        }
        { const float s = ((pa.x + pa.y) + (pa.z + pa.w)) + ((pb.x + pb.y) + (pb.z + pb.w)) + ((pc.x + pc.y) + (pc.z + pc.w)) + ((pd.x + pd.y) + (pd.z + pd.w));
          const float r = rsqrtf(s * (1.f / 1024.f) + EPS);
#pragma unroll
          for (int q = 0; q < 4; ++q) { const v4u raw = vraw[q]; const f32x4 g0 = gq[2 * q], g1 = gq[2 * q + 1];
              LAS bf16* d = VnT + (cq * 32 + q * 8) * 136 + j;
              d[0 * 136] = (bf16)f2bf(bflo(raw.x) * r * g0.x); d[1 * 136] = (bf16)f2bf(bfhi(raw.x) * r * g0.y); d[2 * 136] = (bf16)f2bf(bflo(raw.y) * r * g0.z); d[3 * 136] = (bf16)f2bf(bfhi(raw.y) * r * g0.w);
              d[4 * 136] = (bf16)f2bf(bflo(raw.z) * r * g1.x); d[5 * 136] = (bf16)f2bf(bfhi(raw.z) * r * g1.y); d[6 * 136] = (bf16)f2bf(bflo(raw.w) * r * g1.z); d[7 * 136] = (bf16)f2bf(bfhi(raw.w) * r * g1.w); } }
        unsigned short uc0[16], uc1[16];
#pragma unroll
        for (int r = 0; r < 16; ++r) { uc0[r] = ur0[r]; uc1[r] = ur1[r]; }
        __syncthreads();
        if (u + G < 2048) GM_LOAD(u + G);
        f32x16 acc0 = {}, acc1 = {};
        const int nks = 2 * (ib + 1);
        for (int ks = 0; ks < nks; ++ks) {
            const bf16x8 a = *(const LAS bf16x8*)(WmS + (32 * ib + r32) * 136 + 16 * ks + 8 * hi);
            const bf16x8 b0 = *(const LAS bf16x8*)(VnT + (64 * cb + r32) * 136 + 16 * ks + 8 * hi);
            const bf16x8 b1 = *(const LAS bf16x8*)(VnT + (64 * cb + 32 + r32) * 136 + 16 * ks + 8 * hi);
            acc0 = __builtin_amdgcn_mfma_f32_32x32x16_bf16(a, b0, acc0, 0, 0, 0);
            acc1 = __builtin_amdgcn_mfma_f32_32x32x16_bf16(a, b1, acc1, 0, 0, 0);
        }
#pragma unroll
        for (int r = 0; r < 16; ++r) { const int i = 32 * ib + crow16(r, hi);
            bf16* up = U + (size_t)(m0 + i) * 1024 + g * 128 + 64 * cb + r32;
            const float u0 = __uint_as_float((unsigned)uc0[r] << 16), u1 = __uint_as_float((unsigned)uc1[r] << 16);
            up[0] = (bf16)f2bf(u0 * (acc0[r] + bi[r])); up[32] = (bf16)f2bf(u1 * (acc1[r] + bi[r])); }
        __syncthreads();
    }
#undef GM_LOAD
}
constexpr int AT_KS = 0, AT_VT = 2 * 64 * 72 * 2, AT_BUF = AT_VT + 128 * 72 * 2  , AT_TAB = 2 * AT_BUF, AT_QS = AT_TAB + 1024, AT_LDS = AT_QS + 65536;
static_assert(AT_LDS <= 147456, "attention LDS");
__device__ __forceinline__ void dattn_unit(LAS unsigned char* lds, int b, int h, int qb, const bf16* Q, const bf16* K, const bf16* V, bf16* YB, float lam, const float* subg, float oml, int tid) {
    tid = mk_tid();
    const int lane = tid & 63, w = __builtin_amdgcn_readfirstlane(tid >> 6), ql = lane & 31, hi = lane >> 5;
    const LAS float* tab = (const LAS float*)(lds + AT_TAB);
    const size_t rowb = (size_t)b * SEQ;
    const int qmin = qb * 256 + w * 32, q = qmin + ql, qmax = qmin + 31;
    LAS bf16x8* qs = (LAS bf16x8*)(lds + AT_QS) + w * 512 + lane;
#pragma unroll
    for (int mp = 0; mp < 2; ++mp)
#pragma unroll
        for (int ks = 0; ks < 4; ++ks) qs[(mp * 4 + ks) * 64] = *(const bf16x8*)(Q + (rowb + q) * 1024 + h * 128 + mp * 64 + ks * 16 + hi * 8);
    f32x16 o[2][4];
#pragma unroll
    for (int mp = 0; mp < 2; ++mp)
#pragma unroll
        for (int cb = 0; cb < 4; ++cb) o[mp][cb] = f32x16{};
    float mref[2] = {0.f, 0.f}, lsum[2] = {0.f, 0.f};
    const int NT = 4 * qb + 4;
    const bf16* kg = K + (rowb + (tid >> 3)) * 1024 + h * 128 + (tid & 7) * 8;
    const bf16* vg = V + (rowb + (tid & 63)) * 1024 + h * 128 + (tid >> 6) * 16;
    v4u kr0 = *(const v4u*)(kg), kr1 = *(const v4u*)(kg + 64), vr0 = *(const v4u*)(vg), vr1 = *(const v4u*)(vg + 8);
#define AT_STAGE(BUF) do { LAS bf16* Ks_ = (LAS bf16*)(lds + (BUF) * AT_BUF + AT_KS); LAS bf16* Vt_ = (LAS bf16*)(lds + (BUF) * AT_BUF + AT_VT); \
        *(LAS v4u*)(Ks_ + (tid >> 3) * 72 + (tid & 7) * 8) = kr0; *(LAS v4u*)(Ks_ + 64 * 72 + (tid >> 3) * 72 + (tid & 7) * 8) = kr1; \
        LAS bf16* d = Vt_ + ((tid >> 6) * 16) * 72 + (tid & 63); \
        d[0 * 72] = (bf16)(vr0.x & 0xffffu); d[1 * 72] = (bf16)(vr0.x >> 16); d[2 * 72] = (bf16)(vr0.y & 0xffffu); d[3 * 72] = (bf16)(vr0.y >> 16); \
        d[4 * 72] = (bf16)(vr0.z & 0xffffu); d[5 * 72] = (bf16)(vr0.z >> 16); d[6 * 72] = (bf16)(vr0.w & 0xffffu); d[7 * 72] = (bf16)(vr0.w >> 16); \
        d[8 * 72] = (bf16)(vr1.x & 0xffffu); d[9 * 72] = (bf16)(vr1.x >> 16); d[10 * 72] = (bf16)(vr1.y & 0xffffu); d[11 * 72] = (bf16)(vr1.y >> 16); \
        d[12 * 72] = (bf16)(vr1.z & 0xffffu); d[13 * 72] = (bf16)(vr1.z >> 16); d[14 * 72] = (bf16)(vr1.w & 0xffffu); d[15 * 72] = (bf16)(vr1.w >> 16); } while (0)
    AT_STAGE(0);
    __syncthreads();
    for (int t = 0; t < NT; ++t) {
        if (t + 1 < NT) { const size_t adv = (size_t)(t + 1) * 64 * 1024; kr0 = *(const v4u*)(kg + adv); kr1 = *(const v4u*)(kg + adv + 64); vr0 = *(const v4u*)(vg + adv); vr1 = *(const v4u*)(vg + adv + 8); }
        const LAS bf16* Ks = (const LAS bf16*)(lds + (t & 1) * AT_BUF + AT_KS); const LAS bf16* Vt = (const LAS bf16*)(lds + (t & 1) * AT_BUF + AT_VT);
        const int kvbase = t * 64;
        if (kvbase <= qmax) {
#define AT_SOFTMAX(S, MP, PA, PB) do { \
            float mx = fmaxf(fmaxf(fmaxf(S[0], S[1]), fmaxf(S[2], S[3])), fmaxf(fmaxf(S[4], S[5]), fmaxf(S[6], S[7]))); \
            mx = fmaxf(mx, fmaxf(fmaxf(fmaxf(S[8], S[9]), fmaxf(S[10], S[11])), fmaxf(fmaxf(S[12], S[13]), fmaxf(S[14], S[15])))); \
            { auto rr_ = __builtin_amdgcn_permlane32_swap(__float_as_uint(mx), __float_as_uint(mx), false, false); mx = fmaxf(__uint_as_float(rr_[0]), __uint_as_float(rr_[1])); } \
            if (__any(mx > 60.0f)) { const float dl = fmaxf(mx, 0.f), al = __builtin_amdgcn_exp2f(-dl); mref[MP] += dl; lsum[MP] *= al; \
                _Pragma("unroll") for (int cb = 0; cb < 4; ++cb) o[MP][cb] = o[MP][cb] * al; \
                _Pragma("unroll") for (int r = 0; r < 16; ++r) S[r] -= dl; } \
            float ps = 0.f; \
            _Pragma("unroll") for (int r = 0; r < 16; ++r) { S[r] = __builtin_amdgcn_exp2f(S[r]); ps += S[r]; } \
            lsum[MP] += ps; \
            v4u pw0, pw1; \
            pw0.x = pg8::cvt_pk_bf16(S[0], S[1]); pw0.y = pg8::cvt_pk_bf16(S[2], S[3]); pw0.z = pg8::cvt_pk_bf16(S[4], S[5]); pw0.w = pg8::cvt_pk_bf16(S[6], S[7]); \
            pw1.x = pg8::cvt_pk_bf16(S[8], S[9]); pw1.y = pg8::cvt_pk_bf16(S[10], S[11]); pw1.z = pg8::cvt_pk_bf16(S[12], S[13]); pw1.w = pg8::cvt_pk_bf16(S[14], S[15]); \
            PA = __builtin_bit_cast(bf16x8, pw0); PB = __builtin_bit_cast(bf16x8, pw1); } while (0)
#pragma unroll
        for (int sub = 0; sub < 2; ++sub) {
            if (kvbase + 32 * sub > qmax) continue;
            const bool need_bm = kvbase + 32 * sub + 31 + 113 > qmin;
            LAS bf16x8* qsp = qs; asm volatile("" : "+v"(qsp));
            f32x16 s0, s1;
            { const LAS bf16* kp = Ks + (32 * sub + ql) * 72 + hi * 8;
              if (__any((mref[0] != 0.f) | (mref[1] != 0.f))) {
#pragma unroll
                  for (int r = 0; r < 16; ++r) { s0[r] = -mref[0]; s1[r] = -mref[1]; }
                  s0 = __builtin_amdgcn_mfma_f32_32x32x16_bf16(*(const LAS bf16x8*)kp, qsp[0], s0, 0, 0, 0);
                  s1 = __builtin_amdgcn_mfma_f32_32x32x16_bf16(*(const LAS bf16x8*)(kp + 64 * 72), qsp[4 * 64], s1, 0, 0, 0);
              } else {
                  s0 = __builtin_amdgcn_mfma_f32_32x32x16_bf16(*(const LAS bf16x8*)kp, qsp[0], f32x16{}, 0, 0, 0);
                  s1 = __builtin_amdgcn_mfma_f32_32x32x16_bf16(*(const LAS bf16x8*)(kp + 64 * 72), qsp[4 * 64], f32x16{}, 0, 0, 0);
              } }
#pragma unroll
            for (int ks = 1; ks < 4; ++ks) { const LAS bf16* kp = Ks + (32 * sub + ql) * 72 + ks * 16 + hi * 8;
                s0 = __builtin_amdgcn_mfma_f32_32x32x16_bf16(*(const LAS bf16x8*)kp, qsp[ks * 64], s0, 0, 0, 0);
                s1 = __builtin_amdgcn_mfma_f32_32x32x16_bf16(*(const LAS bf16x8*)(kp + 64 * 72), qsp[(4 + ks) * 64], s1, 0, 0, 0); }
            if (need_bm) { const LAS float* gb = tab + (159 - (q - (kvbase + 32 * sub + 4 * hi)));
#pragma unroll
                for (int r = 0; r < 16; ++r) { const float bv = gb[(r & 3) + 8 * (r >> 2)]; s0[r] += bv; s1[r] += bv; } }
            bf16x8 pA0, pB0, pA1, pB1;
            AT_SOFTMAX(s0, 0, pA0, pB0);
            AT_SOFTMAX(s1, 1, pA1, pB1);
#pragma unroll
            for (int cb = 0; cb < 4; ++cb) { const LAS bf16* vp = Vt + (32 * cb + ql) * 72 + 32 * sub + 4 * hi;
                const v2u a0 = *(const LAS v2u*)(vp), a1 = *(const LAS v2u*)(vp + 8), a2 = *(const LAS v2u*)(vp + 16), a3 = *(const LAS v2u*)(vp + 24);
                const v4u f0 = {a0.x, a0.y, a1.x, a1.y}, f1 = {a2.x, a2.y, a3.x, a3.y};
                o[0][cb] = __builtin_amdgcn_mfma_f32_32x32x16_bf16(__builtin_bit_cast(bf16x8, f0), pA0, o[0][cb], 0, 0, 0);
                o[1][cb] = __builtin_amdgcn_mfma_f32_32x32x16_bf16(__builtin_bit_cast(bf16x8, f0), pA1, o[1][cb], 0, 0, 0);
                o[0][cb] = __builtin_amdgcn_mfma_f32_32x32x16_bf16(__builtin_bit_cast(bf16x8, f1), pB0, o[0][cb], 0, 0, 0);
                o[1][cb] = __builtin_amdgcn_mfma_f32_32x32x16_bf16(__builtin_bit_cast(bf16x8, f1), pB1, o[1][cb], 0, 0, 0); }
        }
#undef AT_SOFTMAX
        }
        if (t + 1 < NT) AT_STAGE((t + 1) & 1);
        __syncthreads();
    }
#undef AT_STAGE
    const float l1 = lsum[0] + __shfl_xor(lsum[0], 32), l2 = lsum[1] + __shfl_xor(lsum[1], 32);
    const float i1 = 1.0f / l1, i2 = lam / l2; float ss = 0.f;
#pragma unroll
    for (int cb = 0; cb < 4; ++cb)
#pragma unroll
        for (int r = 0; r < 16; ++r) { const float y = o[0][cb][r] * i1 - o[1][cb][r] * i2; o[0][cb][r] = y; ss += y * y; }
    ss += __shfl_xor(ss, 32);
    const float rstd = rsqrtf(ss * (1.f / 128.f) + EPS) * oml;
    bf16* op = YB + (rowb + q) * 1024 + h * 128;
#pragma unroll
    for (int cb = 0; cb < 4; ++cb)
#pragma unroll
        for (int rg = 0; rg < 4; ++rg) { const int c = 32 * cb + 8 * rg + 4 * hi; const f32x4 g = *(const f32x4*)(subg + c);
            v2u wv; wv.x = pk2(o[0][cb][4 * rg + 0] * rstd * g.x, o[0][cb][4 * rg + 1] * rstd * g.y); wv.y = pk2(o[0][cb][4 * rg + 2] * rstd * g.z, o[0][cb][4 * rg + 3] * rstd * g.w);
            *(v2u*)(op + c) = wv; }
}
__device__ __forceinline__ void attn_super(LAS unsigned char* lds, int su, const bf16* Q, const bf16* K, const bf16* VA, bf16* YB, const float* tabg, float lam, const float* subg, float oml, int tid) {
    const int bh = su >> 2, b = bh >> 3, h = bh & 7, s = su & 3;
    __syncthreads();
    if (tid < 192) { const int rel = 159 - tid; ((LAS float*)(lds + AT_TAB))[tid] = rel < 0 ? -1e30f : (rel < 128 ? tabg[h * 132 + rel] : 0.f); }
    __syncthreads();
    for (int qi = 0; qi < 4; ++qi) {
        const int qb = (qi == 0) ? s : (qi == 1) ? 7 - s : (qi == 2) ? 8 + s : 15 - s;
        dattn_unit(lds, b, h, qb, Q, K, VA, YB, lam, subg, oml, tid);
    }
    __syncthreads();
}

#define RLX_AGENT __ATOMIC_RELAXED, __HIP_MEMORY_SCOPE_AGENT
#define XB_TMO      128
#define XB_XCNT(j)  (256  + 64 * (j))
#define XB_XSUB(j)  (1280 + 64 * (j))
#define XB_XGEN(j)  (2304 + 64 * (j))
#define XB_TOP      3328
#define XB_TOPGEN   3392
#define XCD_BAR_WORDS 3456
#define XB_SPIN_CAP (1u << 18)

__device__ __forceinline__ unsigned xb_ld(unsigned* p)              { return __hip_atomic_load(p, __ATOMIC_RELAXED, __HIP_MEMORY_SCOPE_AGENT); }
__device__ __forceinline__ unsigned xb_add(unsigned* p, unsigned v) { return __hip_atomic_fetch_add(p, v, __ATOMIC_RELAXED, __HIP_MEMORY_SCOPE_AGENT); }
__device__ __forceinline__ unsigned xb_xcc_id() { return (unsigned)__builtin_amdgcn_s_getreg((3 << 11) | 20) & 0xFu; }
#define XB_SPIN(cond, bar) do { unsigned _sp = 0; while (cond) { __builtin_amdgcn_s_sleep(1); \
    if ((++_sp & 255u) == 0u) { if (xb_ld(&(bar)[XB_TMO])) break; if (_sp > XB_SPIN_CAP) { atomicAdd(&(bar)[XB_TMO], 1u); break; } } } } while (0)

struct XcdBarrier {
    unsigned* bar; unsigned x;
    volatile LAS unsigned* st;
};

__device__ __forceinline__ XcdBarrier xcd_barrier_post(unsigned* bar, volatile LAS unsigned* st) {
    XcdBarrier b; b.bar = bar; b.x = xb_xcc_id(); b.st = st;
    if (threadIdx.x == 0) (void)xb_add(&bar[XB_XCNT(b.x)], 1u);
    return b;
}
__device__ __forceinline__ void xcd_barrier_complete(unsigned* bar, unsigned x, unsigned& nloc, unsigned& nx) {
    const unsigned G = gridDim.x * gridDim.y * gridDim.z;
    unsigned sum, cnt, mine, sp = 0u;
    for (;;) {
        sum = 0u; cnt = 0u; mine = 0u;
#pragma unroll
        for (unsigned j = 0; j < 16; ++j) { const unsigned c = xb_ld(&bar[XB_XCNT(j)]); sum += c; cnt += (c > 0u) ? 1u : 0u; mine = (j == x) ? c : mine; }
        if (sum == G) break;
        __builtin_amdgcn_s_sleep(1);
        if ((++sp & 255u) == 0u) { if (xb_ld(&bar[XB_TMO])) break; if (sp > XB_SPIN_CAP) { atomicAdd(&bar[XB_TMO], 1u); break; } }
    }
    nloc = mine > 0u ? mine : 1u; nx = cnt > 0u ? cnt : 1u;
}

__device__ __forceinline__ void xcd_barrier(const XcdBarrier& b) {
    asm volatile("s_waitcnt vmcnt(0)" ::: "memory");
    __syncthreads();
    if (threadIdx.x == 0) {
        unsigned* bar = b.bar;
        __builtin_amdgcn_s_waitcnt(0);
        unsigned nloc = b.st[0], nx = b.st[1];
        if (nloc == 0u) { xcd_barrier_complete(bar, b.x, nloc, nx); b.st[0] = nloc; b.st[1] = nx; }
        const unsigned old = xb_add(&bar[XB_XSUB(b.x)], 1u);
        const unsigned gen = old / nloc;
        if (old + 1u == (gen + 1u) * nloc) {
            __builtin_amdgcn_fence(__ATOMIC_RELEASE, "agent");
            asm volatile("s_waitcnt vmcnt(0)" ::: "memory");
            const unsigned og = xb_add(&bar[XB_TOP], 1u);
            const unsigned tg = og / nx;
            if (og + 1u == (tg + 1u) * nx) xb_add(&bar[XB_TOPGEN], 1u);
            else XB_SPIN(xb_ld(&bar[XB_TOPGEN]) == tg, bar);
            __builtin_amdgcn_fence(__ATOMIC_ACQUIRE, "agent");
            xb_add(&bar[XB_XGEN(b.x)], 1u);
            asm volatile("s_waitcnt vmcnt(0)" ::: "memory");
        } else {
            XB_SPIN(xb_ld(&bar[XB_XGEN(b.x)]) == gen, bar);
            __builtin_amdgcn_fence(__ATOMIC_ACQUIRE, "agent");
            asm volatile("s_waitcnt vmcnt(0)" ::: "memory");
        }
    }
    __syncthreads();
}

constexpr size_t WS_BAR = 32768;
constexpr int BAR_LDS_OFF = 147456 - 64;
struct Args { const float* in[22]; float* out; unsigned char* ws; int ph_lo, ph_hi; };
constexpr int N_PHASES = 2 + 7 * DEPTH;
__global__ void __launch_bounds__(NWAVES * 64, 2) mk_fwd(Args args) {
    extern __shared__ __attribute__((aligned(16))) unsigned char lds_raw[];
    LAS unsigned char* lds = (LAS unsigned char*)lds_raw;
    typedef const __attribute__((address_space(4))) Args* kargs_t;
    if (threadIdx.x < 16) ((LAS unsigned*)(lds + BAR_LDS_OFF))[threadIdx.x] = 0u;
    __syncthreads();
    const XcdBarrier bar = xcd_barrier_post((unsigned*)(args.ws + WS_BAR), (volatile LAS unsigned*)(lds + BAR_LDS_OFF));
    for (int ph = args.ph_lo; ph < args.ph_hi; ++ph) {
        const int tid = mk_tid(), lane = tid & 63, wave = __builtin_amdgcn_readfirstlane(tid >> 6);
        int G = gridDim.x, bx = blockIdx.x; asm volatile("" : "+s"(G), "+s"(bx));
        const int vcu = (G % 8 == 0) ? (bx % 8) * (G / 8) + bx / 8 : bx;
        const int gw = vcu * NWAVES + wave, NGW = G * NWAVES;
        unsigned long long kp_ = (unsigned long long)__builtin_amdgcn_kernarg_segment_ptr(); asm volatile("" : "+s"(kp_));
        const kargs_t ap = (kargs_t)kp_;
        unsigned char* ws = ap->ws;
        const float* x_in = ap->in[0]; float* xo = ap->out;
        bf16* HB = (bf16*)(ws + WS_HB); bf16* VAb = (bf16*)(ws + WS_VA); bf16* Ub = (bf16*)(ws + WS_U); bf16* Vb = (bf16*)(ws + WS_V); bf16* Qb = (bf16*)(ws + WS_Q); bf16* Kb = (bf16*)(ws + WS_K);
        bf16* TMP = (bf16*)(ws + WS_TMP); bf16* ACT = (bf16*)(ws + WS_ACT);
        float* lamw = (float*)(ws + WS_LAM); float* tabw = (float*)(ws + WS_TAB); float* vss = (float*)(ws + WS_VSS);
        if (ph == 0) {
            LAS float* scr = (LAS float*)(lds + wave * 16384);
            constexpr int I_IN = 16 * (NIN / 32), I_G = 16 * (NGATE / 32), I_S = 16 * 32, I_UP = 16 * (NUP / 32), I_DN = (DFF / 64) * 32, I_L = I_IN + I_G + 3 * I_S + I_UP + I_DN;
            for (int it = gw; it < DEPTH * I_L; it += NGW) {
                const int l = it / I_L; int r = it - l * I_L; bf16* wl = (bf16*)(ws + WS_W + (size_t)l * WL_STRIDE);
                if (r < I_IN) { transpose_item(ap->in[2] + (size_t)l * DM * NIN, DM, NIN, (bf16*)((unsigned char*)wl + WO_IN), false, scr, r, lane); continue; } r -= I_IN;
                if (r < I_G) { transpose_item(ap->in[3] + (size_t)l * DM * NGATE, DM, NGATE, (bf16*)((unsigned char*)wl + WO_G), false, scr, r, lane); continue; } r -= I_G;
                if (r < I_S) { transpose_item(ap->in[13] + (size_t)l * DM * DM, DM, DM, (bf16*)((unsigned char*)wl + WO_A), false, scr, r, lane); continue; } r -= I_S;
                if (r < I_S) { transpose_item(ap->in[14] + (size_t)l * DM * DM, DM, DM, (bf16*)((unsigned char*)wl + WO_B), false, scr, r, lane); continue; } r -= I_S;
                if (r < I_S) { transpose_item(ap->in[15] + (size_t)l * DM * DM, DM, DM, (bf16*)((unsigned char*)wl + WO_O), false, scr, r, lane); continue; } r -= I_S;
                if (r < I_UP) { transpose_item(ap->in[17] + (size_t)l * DM * NUP, DM, NUP, (bf16*)((unsigned char*)wl + WO_UP), true, scr, r, lane); continue; } r -= I_UP;
                transpose_item(ap->in[20] + (size_t)l * DFF * DM, DFF, DM, (bf16*)((unsigned char*)wl + WO_DN), false, scr, r, lane);
            }
            for (int m = gw; m < M; m += 4 * NGW) gain_rows4_bf16(x_in, ap->in[1], HB, (float*)(ws + WS_RSS), (size_t)m, (size_t)NGW, lane);
            if (bx == 0) {
                if (wave < DEPTH) { const int l = wave; const float a = wave_sum(ap->in[7][l * 64 + lane] * ap->in[8][l * 64 + lane]), b = wave_sum(ap->in[9][l * 64 + lane] * ap->in[10][l * 64 + lane]);
                    const float lam_init = 0.8f - 0.6f * expf(-0.3f * (float)l);
                    if (lane == 0) lamw[l] = expf(a) - expf(b) + lam_init; }
                for (int e = tid; e < NHEAD * 132; e += NWAVES * 64) { const int h = e / 132, rel = e - h * 132; const float* rb = ap->in[12];
                    tabw[e] = rel < 128 ? (rb[t5_bucket(rel) * NHEAD + h] - rb[31 * NHEAD + h]) * 1.4426950408889634f : 0.f; }
            }
        } else if (ph == N_PHASES - 1) {
            if (M % (4 * NGW) == 0) { for (int m = gw; m < M; m += 4 * NGW) norm_rows4_f32(xo, ap->in[21], (size_t)m, (size_t)NGW, lane); }
            else for (int m = gw; m < M; m += NGW) norm_row_f32(xo + (size_t)m * DM, ap->in[21], lane);
        } else {
            const int l = (ph - 1) / 7, k = (ph - 1) % 7;
            unsigned char* wl = ws + WS_W + (size_t)l * WL_STRIDE; float* rss = (float*)(ws + WS_RSS);
            if (k == 0) {
                pg8::Gemm g{HB, (const bf16*)(wl + WO_IN), M, NIN, DM}; pg8::StaticOrder S; S.init(M / 256, NIN / 256, G, bx);
                pg8::EpiIn E{Ub, (size_t)(WS_V - WS_U) / 2, VAb, vss, QSCALE, rss};
                pg8::gemm_phase<pg8::EpiIn, pg8::StaticOrder, true, true>(lds, g, S, E);
            } else if (k == 1) {
                const float* gv = ap->in[4] + l * DM; const float* wsl = ap->in[5] + (size_t)l * 8 * 128 * 128; const float* bl = ap->in[6] + l * 8 * 128;
                gmlp_phase(lds, vcu, G, Vb, Ub, vss, gv, wsl, bl, tid);
                const float lam = lamw[l]; const float oml = 1.0f - (0.8f - 0.6f * expf(-0.3f * (float)l));
                for (int su = vcu; su < 256; su += G) attn_super(lds, su, Qb, Kb, VAb, Qb, tabw, lam, ap->in[11] + l * 128, oml, tid);
            } else if (k == 2) {
                pg8::Gemm g{HB, (const bf16*)(wl + WO_G), M, NGATE, DM}; pg8::StaticOrder S; S.init(M / 256, NGATE / 256, G, bx);
                pg8::EpiGate E{Vb, Kb, rss};
                pg8::gemm_phase<pg8::EpiGate, pg8::StaticOrder, true, true>(lds, g, S, E);
            } else if (k == 3) {
                { pg8::Gemm g{Ub, (const bf16*)(wl + WO_A), M, DM, DM}; pg8::StaticOrder S; S.init(M / 256, DM / 256, G, bx);
                  pg8::EpiMerge<0> E{Vb, TMP, nullptr};
                  pg8::gemm_phase<pg8::EpiMerge<0>, pg8::StaticOrder, true, true>(lds, g, S, E); }
                { pg8::Gemm g{Qb, (const bf16*)(wl + WO_B), M, DM, DM}; pg8::StaticOrder S; S.init(M / 256, DM / 256, G, bx);
                  pg8::EpiMerge<1> E{Kb, TMP, VAb};
                  pg8::gemm_phase<pg8::EpiMerge<1>, pg8::StaticOrder, true, true>(lds, g, S, E); }
            } else if (k == 4 || k == 6) {
                pg8::Gemm g{k == 4 ? VAb : ACT, (const bf16*)(wl + (k == 4 ? WO_O : WO_DN)), M, DM, k == 4 ? DM : DFF}; pg8::StaticOrder S; S.init(M / 256, DM / 256, G, bx);
                const bool leave = (k == 4) || (l + 1 < DEPTH);
                pg8::EpiRes E{(l == 0 && k == 4) ? x_in : xo, xo, leave ? HB : nullptr, k == 4 ? ap->in[16] + l * DM : ap->in[1] + (l + 1 < DEPTH ? l + 1 : l) * DM, rss};
                pg8::gemm_phase<pg8::EpiRes, pg8::StaticOrder, true, true>(lds, g, S, E);
            } else {
                pg8::Gemm g{HB, (const bf16*)(wl + WO_UP), M, NUP, DM}; pg8::StaticOrder S; S.init(BATCH * 17, NUP / 256, G, bx, 1);
                pg8::EpiUp E{ACT, ap->in[18] + (size_t)l * 3 * DFF, ap->in[19] + (size_t)l * DFF, (LAS float*)(lds + HALO_OFF), rss};
                pg8::gemm_phase<pg8::EpiUp, pg8::StaticOrder, true, true>(lds, g, S, E);
            }
        }
        if (ph + 1 < args.ph_hi) { if (ph < 0) cg::this_grid().sync(); else xcd_barrier(bar); }
    }
}

extern "C" void kernel_launch(void* const* d_in, const int* in_sizes, int n_in, void* d_out, int out_size, void* d_ws, size_t ws_size, hipStream_t stream) {
    static int grid = 0;
    if (grid == 0) {
        if (n_in != 22 || out_size != M * DM || ws_size < WS_END) { fprintf(stderr, "kernel_launch: unexpected shapes (n_in %d out %d ws %zu)\n", n_in, out_size, ws_size); grid = -1; return; }
        int dev = 0, cus = 0, per_cu = 0;
        if (hipGetDevice(&dev) != hipSuccess || hipDeviceGetAttribute(&cus, hipDeviceAttributeMultiprocessorCount, dev) != hipSuccess) { grid = -1; return; }
        if (hipFuncSetAttribute((const void*)mk_fwd, hipFuncAttributeMaxDynamicSharedMemorySize, LDS_BYTES) != hipSuccess) { fprintf(stderr, "kernel_launch: hipFuncSetAttribute failed\n"); grid = -1; return; }
        if (hipOccupancyMaxActiveBlocksPerMultiprocessor(&per_cu, (const void*)mk_fwd, NWAVES * 64, LDS_BYTES) != hipSuccess || per_cu < 1) { fprintf(stderr, "kernel_launch: occupancy query gave %d\n", per_cu); per_cu = 1; }
        (void)hipGetLastError();
        grid = cus;
    }
    if (grid < 0) return;
    if (hipMemsetAsync((char*)d_ws + WS_BAR, 0, 16384, stream) != hipSuccess) { fprintf(stderr, "kernel_launch: hipMemsetAsync failed\n"); return; }
    Args a{};
    for (int i = 0; i < 22; ++i) a.in[i] = (const float*)d_in[i];
    a.out = (float*)d_out; a.ws = (unsigned char*)d_ws;
#if MK_SINGLE
    a.ph_lo = 0; a.ph_hi = N_PHASES;
    void* kargs[] = {&a};
    const hipError_t e = hipLaunchCooperativeKernel((const void*)mk_fwd, dim3(grid), dim3(NWAVES * 64), kargs, LDS_BYTES, stream);
    if (e != hipSuccess) fprintf(stderr, "kernel_launch: cooperative launch failed: %s (grid %d)\n", hipGetErrorString(e), grid);
#else
    for (int p = 0; p < N_PHASES; ++p) { a.ph_lo = p; a.ph_hi = p + 1; hipLaunchKernelGGL(mk_fwd, dim3(grid), dim3(NWAVES * 64), LDS_BYTES, stream, a); }
#endif
}
```

```cpp
#include <hip/hip_runtime.h>
#include <hip/hip_cooperative_groups.h>
#include <hip/hip_bf16.h>
#include <cstdio>
#include <cstdint>
#include <cmath>
namespace cg = cooperative_groups;
#ifndef MK_SINGLE
#define MK_SINGLE 1
#endif
__device__ __forceinline__ int mk_tid() { int t = threadIdx.x; asm volatile("" : "+v"(t)); return t; }
namespace pg8 {
#define PG8_LAS __attribute__((address_space(3)))
typedef unsigned short bf16_t;
typedef short bf16x8 __attribute__((ext_vector_type(8)));
typedef float f32x4 __attribute__((ext_vector_type(4)));
typedef unsigned u32x4 __attribute__((ext_vector_type(4)));
constexpr int BM = 256, BK = 64, HALF = 128, HTB = HALF * BK * 2  , STAGE_BYTES = 8 * HTB, NXCD = 8, WGM = 8;

__host__ __device__ __forceinline__ int lds_byte(int r, int c) { const int st = (r >> 4) * 2 + (c >> 5), rr = r & 15, cc = c & 31, ob = rr * 64 + cc * 2; return st * 1024 + (ob ^ (((ob >> 9) & 1) << 5)); }
__host__ __device__ __forceinline__ void stage_rc(int b, int& R, int& C) { const int st = b / 1024, sb = b % 1024, swz = sb ^ (((sb >> 9) & 1) << 5); R = (st >> 1) * 16 + swz / 64; C = (st & 1) * 32 + (swz % 64) / 2; }
__host__ __device__ __forceinline__ int perm32(int rho) { const int n = rho >> 4, i = rho & 15; return 8 * (i >> 2) + 4 * n + (i & 3); }

struct Unit { int pm, pn; };
struct Gemm { const bf16_t* A; const bf16_t* Bt; int M, N, K; };

struct StaticOrder {
    int nM, nN, nwg, G, c;
    int amode;
    __host__ __device__ void init(int nM_, int nN_, int G_, int c_, int amode_ = 0) { nM = nM_; nN = nN_; nwg = nM * nN; G = G_; c = c_; amode = amode_; }
    __device__ __forceinline__ long a_byte(const Unit& u, int K) const { const long row = amode ? (long)((u.pm / 17) * 4096 + (u.pm % 17) * 254 - 2) : (long)u.pm * BM; return row * (long)K * 2; }
    __host__ __device__ bool next(int i, Unit& u) const {
        const long L = (long)i * G + c; if (L >= nwg) return false;
        int wgid = (int)L; { const int q = nwg / NXCD, r = nwg % NXCD, xcd = wgid % NXCD, off = wgid / NXCD; wgid = (xcd < r ? xcd * (q + 1) : r * (q + 1) + (xcd - r) * q) + off; }
        const int nig = WGM * nN, gid = wgid / nig, fm = gid * WGM, gsz = (nM - fm) < WGM ? (nM - fm) : WGM;
        u.pm = fm + ((wgid % nig) % gsz); u.pn = (wgid % nig) / gsz; return true;
    }
    __device__ __forceinline__ void a_ready(const Unit&) const {}
    __device__ __forceinline__ void done(const Unit&) const {}
};

typedef float f32x2_t __attribute__((ext_vector_type(2))); typedef __bf16 bf16x2_t __attribute__((ext_vector_type(2)));
__device__ __forceinline__ unsigned cvt_pk_bf16(float lo, float hi) { f32x2_t v = {lo, hi}; bf16x2_t b = __builtin_convertvector(v, bf16x2_t); return __builtin_bit_cast(unsigned, b); }
__device__ __forceinline__ float bf_lo(unsigned w) { return __uint_as_float(w << 16); }
__device__ __forceinline__ float bf_hi(unsigned w) { return __uint_as_float(w & 0xffff0000u); }
__device__ __forceinline__ float gelu_t(float x) {
    const float u = x * (0.7978845608f + 0.0356774081f * x * x);
    const float e = __builtin_amdgcn_exp2f(-2.8853900818f * u);
    return x * __builtin_amdgcn_rcpf(1.0f + e);
}
__device__ __forceinline__ float sigmoid_f(float x) { return __builtin_amdgcn_rcpf(1.0f + __builtin_amdgcn_exp2f(-1.4426950409f * x)); }
__device__ __forceinline__ u32x4 pack8(const f32x4& v0, const f32x4& v1) { u32x4 w; w.x = cvt_pk_bf16(v0[0], v0[1]); w.y = cvt_pk_bf16(v0[2], v0[3]); w.z = cvt_pk_bf16(v1[0], v1[1]); w.w = cvt_pk_bf16(v1[2], v1[3]); return w; }

__device__ __forceinline__ float row_rstd(const float* rss, long row, int fq) {
    const f32x4 p = *(const f32x4*)(rss + row * 16 + fq * 4); float s = (p[0] + p[1]) + (p[2] + p[3]); s += __shfl_xor(s, 16); s += __shfl_xor(s, 32);
    return rsqrtf(s * (1.0f / 1024.0f) + 1e-6f);
}
struct EpiIn {
    static constexpr bool PERM = true, AFTER_DRAIN = false;
    bf16_t* O0; size_t stride; bf16_t* O4; float* vss; float qscale; const float* rss;
    __device__ __forceinline__ void operator()(const f32x4 (&acc)[2][2][4][2], const Unit& u, int wr, int wc, int fr, int fq) const {
        const int t = u.pn >> 2, row0 = u.pm * BM + wr * 64 + fr, col0 = (u.pn & 3) * BM + wc * 32 + 8 * fq;
        bf16_t* base = (t == 4) ? O4 : O0 + (size_t)t * stride;
        const float sc = (t == 2) ? qscale : 1.f;
#pragma unroll
        for (int ai = 0; ai < 2; ++ai)
#pragma unroll
            for (int m = 0; m < 4; ++m) { const int row = row0 + ai * HALF + m * 16; bf16_t* rowp = base + (size_t)row * 1024 + col0; float ss = 0.f; const float rn = row_rstd(rss, row, fq);
#pragma unroll
                for (int bj = 0; bj < 2; ++bj) { f32x4 v0 = acc[ai][bj][m][0] * rn, v1 = acc[ai][bj][m][1] * rn;
                    if (t <= 1) {
#pragma unroll
                        for (int j = 0; j < 4; ++j) { v0[j] = gelu_t(v0[j]); v1[j] = gelu_t(v1[j]); }
#pragma unroll
                        for (int j = 0; j < 4; ++j) ss += v0[j] * v0[j] + v1[j] * v1[j];
                    }
                    v0 = v0 * sc; v1 = v1 * sc;
                    *(u32x4*)(rowp + bj * HALF) = pack8(v0, v1); }
                if (t == 1) { ss += __shfl_xor(ss, 16); ss += __shfl_xor(ss, 32); if (fq == 0) vss[(size_t)row * 16 + (u.pn & 3) * 4 + wc] = ss; } }
    }
};
struct EpiGate {
    static constexpr bool PERM = true, AFTER_DRAIN = false;
    bf16_t* GA; bf16_t* GB; const float* rss;
    __device__ __forceinline__ void operator()(const f32x4 (&acc)[2][2][4][2], const Unit& u, int wr, int wc, int fr, int fq) const {
        const int t = u.pn >> 2, row0 = u.pm * BM + wr * 64 + fr, col0 = (u.pn & 3) * BM + wc * 32 + 8 * fq;
        bf16_t* base = t ? GB : GA;
#pragma unroll
        for (int ai = 0; ai < 2; ++ai)
#pragma unroll
            for (int m = 0; m < 4; ++m) { bf16_t* rowp = base + (size_t)(row0 + ai * HALF + m * 16) * 1024 + col0; const float rn = row_rstd(rss, row0 + ai * HALF + m * 16, fq);
#pragma unroll
                for (int bj = 0; bj < 2; ++bj) { f32x4 v0 = acc[ai][bj][m][0] * rn, v1 = acc[ai][bj][m][1] * rn;
#pragma unroll
                    for (int j = 0; j < 4; ++j) { v0[j] = sigmoid_f(v0[j]); v1[j] = sigmoid_f(v1[j]); }
                    *(u32x4*)(rowp + bj * HALF) = pack8(v0, v1); } }
    }
};
template <int SECOND> struct EpiMerge {
    static constexpr bool PERM = true, AFTER_DRAIN = false;
    const bf16_t* G; bf16_t* T; bf16_t* MG;
    __device__ __forceinline__ void operator()(const f32x4 (&acc)[2][2][4][2], const Unit& u, int wr, int wc, int fr, int fq) const {
        const int row0 = u.pm * BM + wr * 64 + fr, col0 = u.pn * BM + wc * 32 + 8 * fq;
#pragma unroll
        for (int ai = 0; ai < 2; ++ai) {
            u32x4 gpre[4][2], tpre[4][2];
#pragma unroll
            for (int m = 0; m < 4; ++m)
#pragma unroll
                for (int bj = 0; bj < 2; ++bj) { const size_t off = (size_t)(row0 + ai * HALF + m * 16) * 1024 + col0 + bj * HALF; gpre[m][bj] = *(const u32x4*)(G + off); if (SECOND) tpre[m][bj] = *(const u32x4*)(T + off); }
#pragma unroll
            for (int m = 0; m < 4; ++m) { const size_t off = (size_t)(row0 + ai * HALF + m * 16) * 1024 + col0;
#pragma unroll
                for (int bj = 0; bj < 2; ++bj) { const u32x4 gw = gpre[m][bj];
                    f32x4 g0 = {bf_lo(gw.x), bf_hi(gw.x), bf_lo(gw.y), bf_hi(gw.y)}, g1 = {bf_lo(gw.z), bf_hi(gw.z), bf_lo(gw.w), bf_hi(gw.w)};
                    f32x4 v0 = acc[ai][bj][m][0] * g0, v1 = acc[ai][bj][m][1] * g1;
                    bf16_t* tp = T + off + bj * HALF;
                    if (SECOND) { const u32x4 tw = tpre[m][bj]; v0 += (f32x4){bf_lo(tw.x), bf_hi(tw.x), bf_lo(tw.y), bf_hi(tw.y)}; v1 += (f32x4){bf_lo(tw.z), bf_hi(tw.z), bf_lo(tw.w), bf_hi(tw.w)};
                        *(u32x4*)(MG + off + bj * HALF) = pack8(v0, v1); }
                    else { *(u32x4*)tp = pack8(v0, v1); } } }
        }
    }
};
struct EpiRes {
    static constexpr bool PERM = true, AFTER_DRAIN = false;
    const float* base; float* out; bf16_t* XG; const float* gn; float* rss;
    __device__ __forceinline__ void operator()(const f32x4 (&acc)[2][2][4][2], const Unit& u, int wr, int wc, int fr, int fq) const {
        const int row0 = u.pm * BM + wr * 64 + fr, col0 = u.pn * BM + wc * 32 + 8 * fq;
        f32x4 g0[2], g1[2];
        if (XG) {
#pragma unroll
            for (int bj = 0; bj < 2; ++bj) { g0[bj] = *(const f32x4*)(gn + col0 + bj * HALF); g1[bj] = *(const f32x4*)(gn + col0 + bj * HALF + 4); } }
#pragma unroll
        for (int ai = 0; ai < 2; ++ai) {
            f32x4 bpre[4][2][2];
#pragma unroll
            for (int m = 0; m < 4; ++m)
#pragma unroll
                for (int bj = 0; bj < 2; ++bj) { const float* bp = base + (size_t)(row0 + ai * HALF + m * 16) * 1024 + col0 + bj * HALF; bpre[m][bj][0] = *(const f32x4*)bp; bpre[m][bj][1] = *(const f32x4*)(bp + 4); }
#pragma unroll
            for (int m = 0; m < 4; ++m) { const int row = row0 + ai * HALF + m * 16; const size_t off = (size_t)row * 1024 + col0; float ss = 0.f;
#pragma unroll
                for (int bj = 0; bj < 2; ++bj) { float* op = out + off + bj * HALF;
                    const f32x4 x0 = bpre[m][bj][0] + acc[ai][bj][m][0], x1 = bpre[m][bj][1] + acc[ai][bj][m][1];
                    *(f32x4*)op = x0; *(f32x4*)(op + 4) = x1;
                    if (XG) { ss += ((x0[0] * x0[0] + x0[1] * x0[1]) + (x0[2] * x0[2] + x0[3] * x0[3])) + ((x1[0] * x1[0] + x1[1] * x1[1]) + (x1[2] * x1[2] + x1[3] * x1[3]));
                        *(u32x4*)(XG + off + bj * HALF) = pack8(x0 * g0[bj], x1 * g1[bj]); } }
                if (XG) { ss += __shfl_xor(ss, 16); ss += __shfl_xor(ss, 32); if (fq == 0) rss[(size_t)row * 16 + u.pn * 4 + wc] = ss; } }
        }
    }
};
__device__ __forceinline__ float dpp_ror1(float v) { return __int_as_float(__builtin_amdgcn_update_dpp(0, __float_as_int(v), 0x121, 0xf, 0xf, false)); }
__device__ __forceinline__ float dpp_ror2(float v) { return __int_as_float(__builtin_amdgcn_update_dpp(0, __float_as_int(v), 0x122, 0xf, 0xf, false)); }
struct EpiUp {
    static constexpr bool PERM = true, AFTER_DRAIN = false;
    bf16_t* ACT; const float* cw; const float* cb; PG8_LAS float* halo; const float* rss;
    __device__ __forceinline__ void operator()(const f32x4 (&acc)[2][2][4][2], const Unit& u, int wr, int wc, int fr, int fq) const {
        const int b = u.pm / 17, i = u.pm - b * 17, fl = wc * 32 + 8 * fq, f0 = u.pn * 128 + fl;
        float rn[2][4];
#pragma unroll
        for (int ai = 0; ai < 2; ++ai)
#pragma unroll
            for (int m = 0; m < 4; ++m) rn[ai][m] = row_rstd(rss, (long)b * 4096 + 254 * i - 2 + ai * HALF + wr * 64 + m * 16 + fr, fq);
        if (fr >= 14) {
#pragma unroll
            for (int ai = 0; ai < 2; ++ai)
#pragma unroll
                for (int n = 0; n < 2; ++n) *(PG8_LAS f32x4*)(halo + ((ai * 2 + wr) * 2 + (fr - 14)) * 128 + fl + 4 * n) = acc[ai][0][3][n] * rn[ai][3];
        }
        asm volatile("s_waitcnt lgkmcnt(0)" ::: "memory"); __builtin_amdgcn_s_barrier(); asm volatile("" ::: "memory");
        f32x4 w0[2], w1[2], w2[2], bb[2];
#pragma unroll
        for (int n = 0; n < 2; ++n) { w0[n] = *(const f32x4*)(cw + f0 + 4 * n); w1[n] = *(const f32x4*)(cw + 2816 + f0 + 4 * n); w2[n] = *(const f32x4*)(cw + 2 * 2816 + f0 + 4 * n); bb[n] = *(const f32x4*)(cb + f0 + 4 * n); }
#pragma unroll
        for (int ai = 0; ai < 2; ++ai) {
            const int blk = ai * 2 + wr;
            f32x4 pc1[2], pc2[2];
#pragma unroll
            for (int n = 0; n < 2; ++n) { f32x4 hv = {0.f, 0.f, 0.f, 0.f};
                if (blk > 0 && fr >= 14) hv = *(const PG8_LAS f32x4*)(halo + ((blk - 1) * 2 + (fr - 14)) * 128 + fl + 4 * n);
#pragma unroll
                for (int j = 0; j < 4; ++j) { pc1[n][j] = dpp_ror1(hv[j]); pc2[n][j] = dpp_ror2(hv[j]); } }
#pragma unroll
            for (int m = 0; m < 4; ++m) { const int r = ai * HALF + wr * 64 + m * 16 + fr, tk = 254 * i - 2 + r;
                f32x4 o[2];
#pragma unroll
                for (int n = 0; n < 2; ++n) { f32x4 cur = acc[ai][0][m][n] * rn[ai][m]; if (tk < 0) cur = (f32x4){0.f, 0.f, 0.f, 0.f};
#pragma unroll
                    for (int j = 0; j < 4; ++j) { const float c1 = dpp_ror1(cur[j]), c2 = dpp_ror2(cur[j]);
                        const float p1 = fr >= 1 ? c1 : pc1[n][j], p2 = fr >= 2 ? c2 : pc2[n][j]; pc1[n][j] = c1; pc2[n][j] = c2;
                        const float cv = bb[n][j] + w0[n][j] * p2 + w1[n][j] * p1 + w2[n][j] * cur[j];
                        o[n][j] = gelu_t(cv) * (acc[ai][1][m][n][j] * rn[ai][m]); } }
                if (r >= 2 && tk < 4096) *(u32x4*)(ACT + (size_t)(b * 4096 + tk) * 2816 + f0) = pack8(o[0], o[1]); }
        }
    }
};

template <class Epi, class Sched, bool ALIGN_EPI = false, bool SP2 = false>
__device__ __forceinline__ void gemm_phase(PG8_LAS unsigned char* lds, const Gemm g, const Sched& S, const Epi& E) {
    const int tid = mk_tid(), wid = __builtin_amdgcn_readfirstlane(tid >> 6), lane = tid & 63, wr = wid >> 2, wc = wid & 3, fr = lane & 15, fq = lane >> 4;
    const int K = g.K, nt = K / BK;
    unsigned voffA[2], voffB[2];
#pragma unroll
    for (int i = 0; i < 2; ++i) { int R, C; stage_rc(tid * 16 + i * 8192, R, C); const int Rb = Epi::PERM ? ((R & ~31) + perm32(R & 31)) : R;
        voffA[i] = (unsigned)(R * K + C) * 2u; voffB[i] = (unsigned)(Rb * K + C) * 2u; }
    const size_t kstep = (size_t)(BK * 2);
    const size_t hstep = (size_t)HALF * K * 2;
    const size_t tstep = 2 * hstep;
    const unsigned ldsw = (unsigned)wid * 1024u;
    const int aoff = lds_byte(wr * 64 + fr, fq * 8), boff = lds_byte(wc * 32 + fr, fq * 8);
#define PG8_SA(b, h) (((b) * 2 + (h)) * HTB)
#define PG8_SB(b, h) ((4 + (b) * 2 + (h)) * HTB)
#define PG8_STAGE(bufoff, gbase, voff) do { _Pragma("unroll") for (int _i = 0; _i < 2; ++_i) \
        __builtin_amdgcn_global_load_lds((const unsigned*)((const char*)(gbase) + (voff)[_i]), (PG8_LAS unsigned*)(lds + (bufoff) + ldsw + _i * 8192), 16, 0, 0); } while (0)
#define PG8_LDA(dst, b, h) do { _Pragma("unroll") for (int m = 0; m < 4; ++m) _Pragma("unroll") for (int k = 0; k < 2; ++k) dst[m][k] = *(const PG8_LAS bf16x8*)(lds + PG8_SA(b, h) + aoff + m * 2048 + k * 1024); } while (0)
#define PG8_LDB(dst, b, h) do { _Pragma("unroll") for (int n = 0; n < 2; ++n) _Pragma("unroll") for (int k = 0; k < 2; ++k) dst[n][k] = *(const PG8_LAS bf16x8*)(lds + PG8_SB(b, h) + boff + n * 2048 + k * 1024); } while (0)
#define PG8_MMA(ai, bj, At, Bt) do { __builtin_amdgcn_s_setprio(1); _Pragma("unroll") for (int m = 0; m < 4; ++m) _Pragma("unroll") for (int n = 0; n < 2; ++n) _Pragma("unroll") for (int k = 0; k < 2; ++k) \
        acc[ai][bj][m][n] = __builtin_amdgcn_mfma_f32_16x16x32_bf16(Bt[n][k], At[m][k], acc[ai][bj][m][n], 0, 0, 0); __builtin_amdgcn_s_setprio(0); } while (0)
#define PG8_WAIT_V(n) asm volatile("s_waitcnt vmcnt(" #n ")" ::: "memory")
#define PG8_WAIT_L(n) asm volatile("s_waitcnt lgkmcnt(" #n ")" ::: "memory")
#define PG8_BAR __builtin_amdgcn_s_barrier()
#define PG8_SCHED __builtin_amdgcn_sched_barrier(0)
    Unit cur, nxt; int ui = 0;
    if (!S.next(0, cur)) return;
    f32x4 acc[2][2][4][2];
#pragma unroll
    for (int a = 0; a < 2; ++a)
#pragma unroll
        for (int b = 0; b < 2; ++b)
#pragma unroll
            for (int m = 0; m < 4; ++m)
#pragma unroll
                for (int n = 0; n < 2; ++n) acc[a][b][m][n] = (f32x4){0.f, 0.f, 0.f, 0.f};
    bf16x8 At[4][2], B0[2][2], B1[2][2];
    const char* cA = (const char*)g.A + S.a_byte(cur, K); const char* cB = (const char*)g.Bt + (size_t)cur.pn * tstep;
    S.a_ready(cur);
    if constexpr (SP2) {
        PG8_STAGE(PG8_SB(0, 0), cB, voffB); PG8_STAGE(PG8_SB(0, 1), cB + hstep, voffB); PG8_STAGE(PG8_SA(0, 0), cA, voffA); PG8_STAGE(PG8_SA(0, 1), cA + hstep, voffA);
        if (wr == 1) PG8_BAR;
        PG8_WAIT_V(2); PG8_BAR;
        PG8_STAGE(PG8_SB(1, 0), cB + kstep, voffB); PG8_STAGE(PG8_SA(1, 0), cA + kstep, voffA); PG8_STAGE(PG8_SB(1, 1), cB + hstep + kstep, voffB);
        PG8_WAIT_V(6); PG8_BAR;
    } else {
        PG8_STAGE(PG8_SB(0, 0), cB, voffB); PG8_STAGE(PG8_SA(0, 0), cA, voffA); PG8_STAGE(PG8_SB(0, 1), cB + hstep, voffB); PG8_STAGE(PG8_SA(0, 1), cA + hstep, voffA);
        if (wr == 1) PG8_BAR;
        PG8_WAIT_V(4); PG8_BAR;
        PG8_STAGE(PG8_SB(1, 0), cB + kstep, voffB); PG8_STAGE(PG8_SA(1, 0), cA + kstep, voffA); PG8_STAGE(PG8_SB(1, 1), cB + hstep + kstep, voffB);
        PG8_WAIT_V(6); PG8_BAR;
    }
    for (;;) {
        const bool has_next = S.next(ui + 1, nxt);
        const char* nA = has_next ? (const char*)g.A + S.a_byte(nxt, K) : cA; const char* nB = has_next ? (const char*)g.Bt + (size_t)nxt.pn * tstep : cB;
        for (int t = 0; t < nt; t += 2) {
            const bool last = (t == nt - 2);
            const char* a1 = cA + (size_t)(t + 1) * kstep;
            const char* a2 = last ? nA : cA + (size_t)(t + 2) * kstep; const char* b2 = last ? nB : cB + (size_t)(t + 2) * kstep;
            const char* a3 = a2 + kstep; const char* b3 = b2 + kstep;
            if (last && has_next) S.a_ready(nxt);
            if constexpr (SP2) {
            PG8_LDB(B0, 0, 0); PG8_LDB(B1, 0, 1); PG8_SCHED; PG8_LDA(At, 0, 0); PG8_STAGE(PG8_SA(1, 1), a1 + hstep, voffA);
            PG8_WAIT_V(8); PG8_WAIT_L(0); PG8_BAR; PG8_MMA(0, 0, At, B0); PG8_MMA(0, 1, At, B1); PG8_BAR; PG8_SCHED;
            PG8_LDA(At, 0, 1); PG8_STAGE(PG8_SB(0, 0), b2, voffB); PG8_STAGE(PG8_SB(0, 1), b2 + hstep, voffB); PG8_STAGE(PG8_SA(0, 0), a2, voffA);
            PG8_WAIT_V(8); PG8_WAIT_L(0); PG8_BAR; PG8_MMA(1, 0, At, B0); PG8_MMA(1, 1, At, B1); PG8_BAR; PG8_SCHED;
            PG8_LDB(B0, 1, 0); PG8_LDB(B1, 1, 1); PG8_SCHED; PG8_LDA(At, 1, 0); PG8_STAGE(PG8_SA(0, 1), a2 + hstep, voffA);
            PG8_WAIT_V(8); PG8_WAIT_L(0); PG8_BAR; PG8_MMA(0, 0, At, B0); PG8_MMA(0, 1, At, B1); PG8_BAR; PG8_SCHED;
            PG8_LDA(At, 1, 1); PG8_STAGE(PG8_SB(1, 0), b3, voffB); PG8_STAGE(PG8_SB(1, 1), b3 + hstep, voffB); PG8_STAGE(PG8_SA(1, 0), a3, voffA);
            PG8_WAIT_V(8); PG8_WAIT_L(0); PG8_BAR; PG8_MMA(1, 0, At, B0); PG8_MMA(1, 1, At, B1); PG8_BAR; PG8_SCHED;
            } else {
            PG8_LDB(B0, 0, 0); PG8_SCHED; PG8_LDA(At, 0, 0); PG8_STAGE(PG8_SA(1, 1), a1 + hstep, voffA);
            PG8_WAIT_L(8); PG8_BAR; PG8_WAIT_L(0); PG8_MMA(0, 0, At, B0); PG8_BAR; PG8_SCHED;
            PG8_LDB(B1, 0, 1); PG8_STAGE(PG8_SB(0, 0), b2, voffB);
            PG8_BAR; PG8_WAIT_L(0); PG8_MMA(0, 1, At, B1); PG8_BAR;
            PG8_LDA(At, 0, 1); PG8_STAGE(PG8_SA(0, 0), a2, voffA);
            PG8_BAR; PG8_WAIT_L(0); PG8_MMA(1, 0, At, B0); PG8_BAR; PG8_SCHED;
            PG8_STAGE(PG8_SB(0, 1), b2 + hstep, voffB);
            PG8_WAIT_V(6); PG8_BAR; PG8_MMA(1, 1, At, B1); PG8_BAR;
            PG8_LDB(B0, 1, 0); PG8_SCHED; PG8_LDA(At, 1, 0); PG8_STAGE(PG8_SA(0, 1), a2 + hstep, voffA);
            PG8_WAIT_L(8); PG8_BAR; PG8_WAIT_L(0); PG8_MMA(0, 0, At, B0); PG8_BAR; PG8_SCHED;
            PG8_LDB(B1, 1, 1); PG8_STAGE(PG8_SB(1, 0), b3, voffB);
            PG8_BAR; PG8_WAIT_L(0); PG8_MMA(0, 1, At, B1); PG8_BAR;
            PG8_LDA(At, 1, 1); PG8_STAGE(PG8_SA(1, 0), a3, voffA);
            PG8_BAR; PG8_WAIT_L(0); PG8_MMA(1, 0, At, B0); PG8_BAR; PG8_SCHED;
            PG8_STAGE(PG8_SB(1, 1), b3 + hstep, voffB);
            PG8_WAIT_V(6); PG8_BAR; PG8_MMA(1, 1, At, B1); PG8_BAR;
            }
        }
        if constexpr (ALIGN_EPI) { if (wr == 0) PG8_BAR; }
        if constexpr (!Epi::AFTER_DRAIN) { E(acc, cur, wr, wc, fr, fq); S.done(cur); }
        if (!has_next) break;
#pragma unroll
        for (int a = 0; a < 2; ++a)
#pragma unroll
            for (int b = 0; b < 2; ++b)
#pragma unroll
                for (int m = 0; m < 4; ++m)
#pragma unroll
                    for (int n = 0; n < 2; ++n) acc[a][b][m][n] = (f32x4){0.f, 0.f, 0.f, 0.f};
        cur = nxt; cA = nA; cB = nB; ++ui;
        if constexpr (ALIGN_EPI) { if (wr == 1) PG8_BAR; }
    }
    PG8_WAIT_V(0);
    if constexpr (!ALIGN_EPI) { if (wr == 0) PG8_BAR; }
    PG8_BAR;
    if constexpr (Epi::AFTER_DRAIN) { E.fused(acc, cur, wr, wc, fr, fq, lds, wid, lane); S.done(cur); }
#undef PG8_SA
#undef PG8_SB
#undef PG8_STAGE
#undef PG8_LDA
#undef PG8_LDB
#undef PG8_MMA
#undef PG8_WAIT_V
#undef PG8_WAIT_L
#undef PG8_BAR
#undef PG8_SCHED
}
}

#define GAS __attribute__((address_space(1)))
#define LAS __attribute__((address_space(3)))
typedef unsigned short bf16;
typedef unsigned v4u __attribute__((ext_vector_type(4)));
typedef unsigned v2u __attribute__((ext_vector_type(2)));
typedef float f32x4 __attribute__((ext_vector_type(4)));
typedef short bf16x8 __attribute__((ext_vector_type(8)));
typedef float f32x16 __attribute__((ext_vector_type(16)));
#define LDS_WAIT() asm volatile("s_waitcnt lgkmcnt(0)" ::: "memory")
#define VM_WAIT() asm volatile("s_waitcnt vmcnt(0)" ::: "memory")
__device__ __forceinline__ unsigned f2bf(float f) { unsigned u = __builtin_bit_cast(unsigned, f); return (u + 0x7fffu + ((u >> 16) & 1u)) >> 16; }
__device__ __forceinline__ unsigned pk2(float lo, float hi) { return f2bf(lo) | (f2bf(hi) << 16); }
__device__ __forceinline__ float bflo(unsigned w) { return __uint_as_float(w << 16); }
__device__ __forceinline__ float bfhi(unsigned w) { return __uint_as_float(w & 0xffff0000u); }

constexpr int NWAVES = 8;
constexpr int BATCH = 8, SEQ = 4096, DM = 1024, M = BATCH * SEQ, NIN = 5120, NGATE = 2048, DFF = 2816, NUP = 2 * DFF, DEPTH = 2, NHEAD = 8;
constexpr float EPS = 1e-6f;
constexpr float QSCALE = 0.125f * 1.4426950408889634f;
constexpr size_t MiB = 1u << 20;
constexpr size_t WS_LAM = 0, WS_TAB = 4096, WS_VSS = 1 * MiB;
constexpr size_t WS_W = 4 * MiB, WL_STRIDE = 38273024;
constexpr size_t WO_IN = 0, WO_G = 10 * MiB, WO_A = 14 * MiB, WO_B = 16 * MiB, WO_O = 18 * MiB, WO_UP = 20 * MiB, WO_DN = 31 * MiB;
constexpr size_t WS_RSS = 78 * MiB;
constexpr size_t WS_HB = 112 * MiB, WS_VA = 176 * MiB, WS_U = 240 * MiB, WS_V = 304 * MiB, WS_Q = 368 * MiB, WS_K = 432 * MiB;
constexpr size_t WS_TMP = WS_HB;
constexpr size_t WS_YA = WS_U, WS_MG = WS_U, WS_GA = WS_V, WS_YB = WS_Q, WS_GB = WS_K;
constexpr size_t WS_ACT = WS_U;
constexpr size_t WS_END = 496 * MiB;
constexpr int RING_BYTES = 131072, HALO_OFF = RING_BYTES + 1024, LDS_BYTES = 147456;

__device__ __forceinline__ float wave_sum(float v) {
#pragma unroll
    for (int o = 1; o < 64; o <<= 1) v += __shfl_xor(v, o);
    return v;
}
__device__ __forceinline__ void transpose_item(const float* W, int K, int N, bf16* WT, bool upmap, LAS float* scr, int item, int lane) {
    const int nblk = N / 32, kb = item / nblk, nb = item % nblk, k0 = 64 * kb, n0 = 32 * nb;
    int d0 = n0;
    if (upmap) { const int f = n0 < DFF ? n0 : n0 - DFF; d0 = (f >> 7) * 256 + (f & 127) + (n0 < DFF ? 0 : 128); }
#pragma unroll 8
    for (int i = 0; i < 32; ++i) { const int kk = 2 * i + (lane >> 5); scr[kk * 33 + (lane & 31)] = W[(size_t)(k0 + kk) * N + n0 + (lane & 31)]; }
    LDS_WAIT(); asm volatile("" ::: "memory");
    const int c = lane & 7;
#pragma unroll
    for (int j = 0; j < 4; ++j) { const int n = (lane >> 3) + 8 * j; const LAS float* s = scr + (8 * c) * 33 + n;
        v4u o; o.x = pk2(s[0 * 33], s[1 * 33]); o.y = pk2(s[2 * 33], s[3 * 33]); o.z = pk2(s[4 * 33], s[5 * 33]); o.w = pk2(s[6 * 33], s[7 * 33]);
        *(GAS v4u*)(WT + (size_t)(d0 + n) * K + k0 + 8 * c) = o; }
    LDS_WAIT(); asm volatile("" ::: "memory");
}
__device__ __forceinline__ void norm_row_bf16(const float* xrow, const float* g, bf16* orow, int lane) {
    const f32x4* xr = (const f32x4*)xrow + lane; const f32x4* gr = (const f32x4*)g + lane;
    f32x4 v[4]; float s2 = 0.f;
#pragma unroll
    for (int j = 0; j < 4; ++j) { v[j] = xr[64 * j]; s2 += (v[j].x * v[j].x + v[j].y * v[j].y) + (v[j].z * v[j].z + v[j].w * v[j].w); }
    const float rstd = rsqrtf(wave_sum(s2) * (1.f / DM) + EPS);
    v2u* o8 = (v2u*)orow + lane;
#pragma unroll
    for (int j = 0; j < 4; ++j) { const f32x4 gg = gr[64 * j]; v2u w; w.x = pk2(v[j].x * rstd * gg.x, v[j].y * rstd * gg.y); w.y = pk2(v[j].z * rstd * gg.z, v[j].w * rstd * gg.w); o8[64 * j] = w; }
}
__device__ __forceinline__ void norm_row_f32(float* xrow, const float* g, int lane) {
    f32x4* xr = (f32x4*)xrow + lane; const f32x4* gr = (const f32x4*)g + lane;
    f32x4 v[4]; float s2 = 0.f;
#pragma unroll
    for (int j = 0; j < 4; ++j) { v[j] = xr[64 * j]; s2 += (v[j].x * v[j].x + v[j].y * v[j].y) + (v[j].z * v[j].z + v[j].w * v[j].w); }
    const float rstd = rsqrtf(wave_sum(s2) * (1.f / DM) + EPS);
#pragma unroll
    for (int j = 0; j < 4; ++j) xr[64 * j] = v[j] * rstd * gr[64 * j];
}
__device__ __forceinline__ void norm_rows4_bf16(const float* x, const float* g, bf16* o, size_t m, size_t rs, int lane) {
    f32x4 v[4][4]; float s2[4];
#pragma unroll
    for (int r = 0; r < 4; ++r) { const f32x4* xr = (const f32x4*)(x + (m + r * rs) * DM) + lane;
#pragma unroll
        for (int j = 0; j < 4; ++j) v[r][j] = xr[64 * j]; }
    const f32x4* gr = (const f32x4*)g + lane; f32x4 gg[4];
#pragma unroll
    for (int j = 0; j < 4; ++j) gg[j] = gr[64 * j];
#pragma unroll
    for (int r = 0; r < 4; ++r) { s2[r] = 0.f;
#pragma unroll
        for (int j = 0; j < 4; ++j) s2[r] += (v[r][j].x * v[r][j].x + v[r][j].y * v[r][j].y) + (v[r][j].z * v[r][j].z + v[r][j].w * v[r][j].w); }
#pragma unroll
    for (int r = 0; r < 4; ++r) { const float rstd = rsqrtf(wave_sum(s2[r]) * (1.f / DM) + EPS); v2u* o8 = (v2u*)(o + (m + r * rs) * DM) + lane;
#pragma unroll
        for (int j = 0; j < 4; ++j) { v2u w; w.x = pk2(v[r][j].x * rstd * gg[j].x, v[r][j].y * rstd * gg[j].y); w.y = pk2(v[r][j].z * rstd * gg[j].z, v[r][j].w * rstd * gg[j].w); o8[64 * j] = w; } }
}
__device__ __forceinline__ void norm_rows4_f32(float* x, const float* g, size_t m, size_t rs, int lane) {
    f32x4 v[4][4]; float s2[4];
#pragma unroll
    for (int r = 0; r < 4; ++r) { const f32x4* xr = (const f32x4*)(x + (m + r * rs) * DM) + lane;
#pragma unroll
        for (int j = 0; j < 4; ++j) v[r][j] = xr[64 * j]; }
    const f32x4* gr = (const f32x4*)g + lane; f32x4 gg[4];
#pragma unroll
    for (int j = 0; j < 4; ++j) gg[j] = gr[64 * j];
#pragma unroll
    for (int r = 0; r < 4; ++r) { s2[r] = 0.f;
#pragma unroll
        for (int j = 0; j < 4; ++j) s2[r] += (v[r][j].x * v[r][j].x + v[r][j].y * v[r][j].y) + (v[r][j].z * v[r][j].z + v[r][j].w * v[r][j].w); }
#pragma unroll
    for (int r = 0; r < 4; ++r) { const float rstd = rsqrtf(wave_sum(s2[r]) * (1.f / DM) + EPS); f32x4* xr = (f32x4*)(x + (m + r * rs) * DM) + lane;
#pragma unroll
        for (int j = 0; j < 4; ++j) xr[64 * j] = v[r][j] * rstd * gg[j]; }
}
__device__ __forceinline__ void gain_rows4_bf16(const float* x, const float* g, bf16* o, float* rss, size_t m, size_t rs, int lane) {
    f32x4 v[4][4];
#pragma unroll
    for (int r = 0; r < 4; ++r) { const f32x4* xr = (const f32x4*)(x + (m + r * rs) * DM) + lane;
#pragma unroll
        for (int j = 0; j < 4; ++j) v[r][j] = xr[64 * j]; }
    const f32x4* gr = (const f32x4*)g + lane; f32x4 gg[4];
#pragma unroll
    for (int j = 0; j < 4; ++j) gg[j] = gr[64 * j];
#pragma unroll
    for (int r = 0; r < 4; ++r) { float s2 = 0.f; v2u* o8 = (v2u*)(o + (m + r * rs) * DM) + lane;
#pragma unroll
        for (int j = 0; j < 4; ++j) { s2 += (v[r][j].x * v[r][j].x + v[r][j].y * v[r][j].y) + (v[r][j].z * v[r][j].z + v[r][j].w * v[r][j].w);
            v2u w; w.x = pk2(v[r][j].x * gg[j].x, v[r][j].y * gg[j].y); w.y = pk2(v[r][j].z * gg[j].z, v[r][j].w * gg[j].w); o8[64 * j] = w; }
        s2 = wave_sum(s2); if (lane < 16) rss[(m + r * rs) * 16 + lane] = lane == 0 ? s2 : 0.f; }
}
__device__ __forceinline__ int t5_bucket(int n) {
    if (n < 16) return n;
    int b = 15;
    b += (n >= 16) + (n >= 19) + (n >= 21) + (n >= 24) + (n >= 27) + (n >= 31) + (n >= 35) + (n >= 40) + (n >= 46) + (n >= 52) + (n >= 59) + (n >= 67) + (n >= 77) + (n >= 87) + (n >= 99) + (n >= 113);
    return b;
}
__device__ __forceinline__ int crow16(int r, int hi) { return (r & 3) + 8 * (r >> 2) + 4 * hi; }
__device__ __forceinline__ void gmlp_phase(LAS unsigned char* lds, int vcu, int G, const bf16* V, bf16* U, const float* vss, const float* gv, const float* wsl, const float* bl, int tid) {
    LAS bf16* WmS = (LAS bf16*)lds;
    LAS bf16* VnT = (LAS bf16*)(lds + 34816);
    const int lane = tid & 63, w = tid >> 6, ib = w >> 1, cb = w & 1, r32 = lane & 31, hi = lane >> 5, j = tid & 127, cq = tid >> 7;
    if (vcu >= 2048) return;
    v4u vraw[4]; f32x4 pa, pb, pc, pd; unsigned short ur0[16], ur1[16];
#define GM_LOAD(UU) do { const int m0_ = ((UU) >> 3) * 128, g_ = (UU) & 7; const bf16* src_ = V + (size_t)(m0_ + j) * 1024 + g_ * 128 + cq * 32; \
        _Pragma("unroll") for (int q = 0; q < 4; ++q) vraw[q] = *(const v4u*)(src_ + q * 8); \
        const f32x4* pp_ = (const f32x4*)(vss + (size_t)(m0_ + j) * 16); pa = pp_[0]; pb = pp_[1]; pc = pp_[2]; pd = pp_[3]; \
        _Pragma("unroll") for (int r = 0; r < 16; ++r) { const bf16* up_ = U + (size_t)(m0_ + 32 * ib + crow16(r, hi)) * 1024 + g_ * 128 + 64 * cb + r32; ur0[r] = up_[0]; ur1[r] = up_[32]; } } while (0)
    GM_LOAD(vcu);
    int g_cur = -1; f32x4 gq[8]; float bi[16];
    for (int u = vcu; u < 2048; u += G) {
        const int m0 = (u >> 3) * 128, g = u & 7;
        if (g != g_cur) {
            g_cur = g; const float* wsg = wsl + g * 128 * 128; const float* gp = gv + g * 128 + cq * 32;
#pragma unroll
            for (int k = 0; k < 8; ++k) { const int p = tid + 512 * k, i = p >> 5, j4 = (p & 31) * 4; f32x4 x = *(const f32x4*)(wsg + i * 128 + j4);
                if (j4 + 0 > i) x.x = 0.f; if (j4 + 1 > i) x.y = 0.f; if (j4 + 2 > i) x.z = 0.f; if (j4 + 3 > i) x.w = 0.f;
                v2u o; o.x = pk2(x.x, x.y); o.y = pk2(x.z, x.w); *(LAS v2u*)(WmS + i * 136 + j4) = o; }
#pragma unroll
            for (int q = 0; q < 8; ++q) gq[q] = *(const f32x4*)(gp + q * 4);
#pragma unroll
            for (int r = 0; r < 16; ++r) bi[r] = bl[g * 128 + 32 * ib + crow16(r, hi)];
        }
        { const float s = ((pa.x + pa.y) + (pa.z + pa.w)) + ((pb.x + pb.y) + (pb.z + pb.w)) + ((pc.x + pc.y) + (pc.z + pc.w)) + ((pd.x + pd.y) + (pd.z + pd.w));
          const float r = rsqrtf(s * (1.f / 1024.f) + EPS);
#pragma unroll
          for (int q = 0; q < 4; ++q) { const v4u raw = vraw[q]; const f32x4 g0 = gq[2 * q], g1 = gq[2 * q + 1];
              LAS bf16* d = VnT + (cq * 32 + q * 8) * 136 + j;
              d[0 * 136] = (bf16)f2bf(bflo(raw.x) * r * g0.x); d[1 * 136] = (bf16)f2bf(bfhi(raw.x) * r * g0.y); d[2 * 136] = (bf16)f2bf(bflo(raw.y) * r * g0.z); d[3 * 136] = (bf16)f2bf(bfhi(raw.y) * r * g0.w);
              d[4 * 136] = (bf16)f2bf(bflo(raw.z) * r * g1.x); d[5 * 136] = (bf16)f2bf(bfhi(raw.z) * r * g1.y); d[6 * 136] = (bf16)f2bf(bflo(raw.w) * r * g1.z); d[7 * 136] = (bf16)f2bf(bfhi(raw.w) * r * g1.w); } }
        unsigned short uc0[16], uc1[16];
#pragma unroll
        for (int r = 0; r < 16; ++r) { uc0[r] = ur0[r]; uc1[r] = ur1[r]; }
        __syncthreads();
        if (u + G < 2048) GM_LOAD(u + G);
        f32x16 acc0 = {}, acc1 = {};
        const int nks = 2 * (ib + 1);
        for (int ks = 0; ks < nks; ++ks) {
            const bf16x8 a = *(const LAS bf16x8*)(WmS + (32 * ib + r32) * 136 + 16 * ks + 8 * hi);
            const bf16x8 b0 = *(const LAS bf16x8*)(VnT + (64 * cb + r32) * 136 + 16 * ks + 8 * hi);
            const bf16x8 b1 = *(const LAS bf16x8*)(VnT + (64 * cb + 32 + r32) * 136 + 16 * ks + 8 * hi);
            acc0 = __builtin_amdgcn_mfma_f32_32x32x16_bf16(a, b0, acc0, 0, 0, 0);
            acc1 = __builtin_amdgcn_mfma_f32_32x32x16_bf16(a, b1, acc1, 0, 0, 0);
        }
#pragma unroll
        for (int r = 0; r < 16; ++r) { const int i = 32 * ib + crow16(r, hi);
            bf16* up = U + (size_t)(m0 + i) * 1024 + g * 128 + 64 * cb + r32;
            const float u0 = __uint_as_float((unsigned)uc0[r] << 16), u1 = __uint_as_float((unsigned)uc1[r] << 16);
            up[0] = (bf16)f2bf(u0 * (acc0[r] + bi[r])); up[32] = (bf16)f2bf(u1 * (acc1[r] + bi[r])); }
        __syncthreads();
    }
#undef GM_LOAD
}
constexpr int AT_KS = 0, AT_VT = 2 * 64 * 72 * 2, AT_BUF = AT_VT + 128 * 72 * 2  , AT_TAB = 2 * AT_BUF, AT_QS = AT_TAB + 1024, AT_LDS = AT_QS + 65536;
static_assert(AT_LDS <= 147456, "attention LDS");
__device__ __forceinline__ void dattn_unit(LAS unsigned char* lds, int b, int h, int qb, const bf16* Q, const bf16* K, const bf16* V, bf16* YB, float lam, const float* subg, float oml, int tid) {
    tid = mk_tid();
    const int lane = tid & 63, w = __builtin_amdgcn_readfirstlane(tid >> 6), ql = lane & 31, hi = lane >> 5;
    const LAS float* tab = (const LAS float*)(lds + AT_TAB);
    const size_t rowb = (size_t)b * SEQ;
    const int qmin = qb * 256 + w * 32, q = qmin + ql, qmax = qmin + 31;
    LAS bf16x8* qs = (LAS bf16x8*)(lds + AT_QS) + w * 512 + lane;
#pragma unroll
    for (int mp = 0; mp < 2; ++mp)
#pragma unroll
        for (int ks = 0; ks < 4; ++ks) qs[(mp * 4 + ks) * 64] = *(const bf16x8*)(Q + (rowb + q) * 1024 + h * 128 + mp * 64 + ks * 16 + hi * 8);
    f32x16 o[2][4];
#pragma unroll
    for (int mp = 0; mp < 2; ++mp)
#pragma unroll
        for (int cb = 0; cb < 4; ++cb) o[mp][cb] = f32x16{};
    float mref[2] = {0.f, 0.f}, lsum[2] = {0.f, 0.f};
    const int NT = 4 * qb + 4;
    const bf16* kg = K + (rowb + (tid >> 3)) * 1024 + h * 128 + (tid & 7) * 8;
    const bf16* vg = V + (rowb + (tid & 63)) * 1024 + h * 128 + (tid >> 6) * 16;
    v4u kr0 = *(const v4u*)(kg), kr1 = *(const v4u*)(kg + 64), vr0 = *(const v4u*)(vg), vr1 = *(const v4u*)(vg + 8);
#define AT_STAGE(BUF) do { LAS bf16* Ks_ = (LAS bf16*)(lds + (BUF) * AT_BUF + AT_KS); LAS bf16* Vt_ = (LAS bf16*)(lds + (BUF) * AT_BUF + AT_VT); \
        *(LAS v4u*)(Ks_ + (tid >> 3) * 72 + (tid & 7) * 8) = kr0; *(LAS v4u*)(Ks_ + 64 * 72 + (tid >> 3) * 72 + (tid & 7) * 8) = kr1; \
        LAS bf16* d = Vt_ + ((tid >> 6) * 16) * 72 + (tid & 63); \
        d[0 * 72] = (bf16)(vr0.x & 0xffffu); d[1 * 72] = (bf16)(vr0.x >> 16); d[2 * 72] = (bf16)(vr0.y & 0xffffu); d[3 * 72] = (bf16)(vr0.y >> 16); \
        d[4 * 72] = (bf16)(vr0.z & 0xffffu); d[5 * 72] = (bf16)(vr0.z >> 16); d[6 * 72] = (bf16)(vr0.w & 0xffffu); d[7 * 72] = (bf16)(vr0.w >> 16); \
        d[8 * 72] = (bf16)(vr1.x & 0xffffu); d[9 * 72] = (bf16)(vr1.x >> 16); d[10 * 72] = (bf16)(vr1.y & 0xffffu); d[11 * 72] = (bf16)(vr1.y >> 16); \
        d[12 * 72] = (bf16)(vr1.z & 0xffffu); d[13 * 72] = (bf16)(vr1.z >> 16); d[14 * 72] = (bf16)(vr1.w & 0xffffu); d[15 * 72] = (bf16)(vr1.w >> 16); } while (0)
    AT_STAGE(0);
    __syncthreads();
    for (int t = 0; t < NT; ++t) {
        if (t + 1 < NT) { const size_t adv = (size_t)(t + 1) * 64 * 1024; kr0 = *(const v4u*)(kg + adv); kr1 = *(const v4u*)(kg + adv + 64); vr0 = *(const v4u*)(vg + adv); vr1 = *(const v4u*)(vg + adv + 8); }
        const LAS bf16* Ks = (const LAS bf16*)(lds + (t & 1) * AT_BUF + AT_KS); const LAS bf16* Vt = (const LAS bf16*)(lds + (t & 1) * AT_BUF + AT_VT);
        const int kvbase = t * 64;
        if (kvbase <= qmax) {
#define AT_SOFTMAX(S, MP, PA, PB) do { \
            bool big_ = false; \
            _Pragma("unroll") for (int r = 0; r < 16; ++r) big_ |= (S[r] > 8.0f);     \
            if (__any(big_)) { \
            float mx = fmaxf(fmaxf(fmaxf(S[0], S[1]), fmaxf(S[2], S[3])), fmaxf(fmaxf(S[4], S[5]), fmaxf(S[6], S[7]))); \
            mx = fmaxf(mx, fmaxf(fmaxf(fmaxf(S[8], S[9]), fmaxf(S[10], S[11])), fmaxf(fmaxf(S[12], S[13]), fmaxf(S[14], S[15])))); \
            { auto rr_ = __builtin_amdgcn_permlane32_swap(__float_as_uint(mx), __float_as_uint(mx), false, false); mx = fmaxf(__uint_as_float(rr_[0]), __uint_as_float(rr_[1])); } \
            const float dl = fmaxf(mx, 0.f), al = __builtin_amdgcn_exp2f(-dl); mref[MP] += dl; lsum[MP] *= al; \
                _Pragma("unroll") for (int cb = 0; cb < 4; ++cb) o[MP][cb] = o[MP][cb] * al; \
                _Pragma("unroll") for (int r = 0; r < 16; ++r) S[r] -= dl; } \
            float ps = 0.f; \
            _Pragma("unroll") for (int r = 0; r < 16; ++r) { S[r] = __builtin_amdgcn_exp2f(S[r]); ps += S[r]; } \
            lsum[MP] += ps; \
            v4u pw0, pw1; \
            pw0.x = pg8::cvt_pk_bf16(S[0], S[1]); pw0.y = pg8::cvt_pk_bf16(S[2], S[3]); pw0.z = pg8::cvt_pk_bf16(S[4], S[5]); pw0.w = pg8::cvt_pk_bf16(S[6], S[7]); \
            pw1.x = pg8::cvt_pk_bf16(S[8], S[9]); pw1.y = pg8::cvt_pk_bf16(S[10], S[11]); pw1.z = pg8::cvt_pk_bf16(S[12], S[13]); pw1.w = pg8::cvt_pk_bf16(S[14], S[15]); \
            PA = __builtin_bit_cast(bf16x8, pw0); PB = __builtin_bit_cast(bf16x8, pw1); } while (0)
#pragma unroll
        for (int sub = 0; sub < 2; ++sub) {
            if (kvbase + 32 * sub > qmax) continue;
            const bool need_bm = kvbase + 32 * sub + 31 + 113 > qmin;
            LAS bf16x8* qsp = qs; asm volatile("" : "+v"(qsp));
            f32x16 s0, s1;
#pragma unroll
            for (int r = 0; r < 16; ++r) { s0[r] = -mref[0]; s1[r] = -mref[1]; }
#pragma unroll
            for (int ks = 0; ks < 4; ++ks) { const LAS bf16* kp = Ks + (32 * sub + ql) * 72 + ks * 16 + hi * 8;
                s0 = __builtin_amdgcn_mfma_f32_32x32x16_bf16(*(const LAS bf16x8*)kp, qsp[ks * 64], s0, 0, 0, 0);
                s1 = __builtin_amdgcn_mfma_f32_32x32x16_bf16(*(const LAS bf16x8*)(kp + 64 * 72), qsp[(4 + ks) * 64], s1, 0, 0, 0); }
            if (need_bm) { const LAS float* gb = tab + (159 - (q - (kvbase + 32 * sub + 4 * hi)));
#pragma unroll
                for (int r = 0; r < 16; ++r) { const float bv = gb[(r & 3) + 8 * (r >> 2)]; s0[r] += bv; s1[r] += bv; } }
            bf16x8 pA0, pB0, pA1, pB1;
            AT_SOFTMAX(s0, 0, pA0, pB0);
            AT_SOFTMAX(s1, 1, pA1, pB1);
#pragma unroll
            for (int cb = 0; cb < 4; ++cb) { const LAS bf16* vp = Vt + (32 * cb + ql) * 72 + 32 * sub + 4 * hi;
                const v2u a0 = *(const LAS v2u*)(vp), a1 = *(const LAS v2u*)(vp + 8), a2 = *(const LAS v2u*)(vp + 16), a3 = *(const LAS v2u*)(vp + 24);
                const v4u f0 = {a0.x, a0.y, a1.x, a1.y}, f1 = {a2.x, a2.y, a3.x, a3.y};
                o[0][cb] = __builtin_amdgcn_mfma_f32_32x32x16_bf16(__builtin_bit_cast(bf16x8, f0), pA0, o[0][cb], 0, 0, 0);
                o[1][cb] = __builtin_amdgcn_mfma_f32_32x32x16_bf16(__builtin_bit_cast(bf16x8, f0), pA1, o[1][cb], 0, 0, 0);
                o[0][cb] = __builtin_amdgcn_mfma_f32_32x32x16_bf16(__builtin_bit_cast(bf16x8, f1), pB0, o[0][cb], 0, 0, 0);
                o[1][cb] = __builtin_amdgcn_mfma_f32_32x32x16_bf16(__builtin_bit_cast(bf16x8, f1), pB1, o[1][cb], 0, 0, 0); }
        }
#undef AT_SOFTMAX
        }
        if (t + 1 < NT) AT_STAGE((t + 1) & 1);
        __syncthreads();
    }
#undef AT_STAGE
    const float l1 = lsum[0] + __shfl_xor(lsum[0], 32), l2 = lsum[1] + __shfl_xor(lsum[1], 32);
    const float i1 = 1.0f / l1, i2 = lam / l2; float ss = 0.f;
#pragma unroll
    for (int cb = 0; cb < 4; ++cb)
#pragma unroll
        for (int r = 0; r < 16; ++r) { const float y = o[0][cb][r] * i1 - o[1][cb][r] * i2; o[0][cb][r] = y; ss += y * y; }
    ss += __shfl_xor(ss, 32);
    const float rstd = rsqrtf(ss * (1.f / 128.f) + EPS) * oml;
    bf16* op = YB + (rowb + q) * 1024 + h * 128;
#pragma unroll
    for (int cb = 0; cb < 4; ++cb)
#pragma unroll
        for (int rg = 0; rg < 4; ++rg) { const int c = 32 * cb + 8 * rg + 4 * hi; const f32x4 g = *(const f32x4*)(subg + c);
            v2u wv; wv.x = pk2(o[0][cb][4 * rg + 0] * rstd * g.x, o[0][cb][4 * rg + 1] * rstd * g.y); wv.y = pk2(o[0][cb][4 * rg + 2] * rstd * g.z, o[0][cb][4 * rg + 3] * rstd * g.w);
            *(v2u*)(op + c) = wv; }
}
__device__ __forceinline__ void attn_super(LAS unsigned char* lds, int su, const bf16* Q, const bf16* K, const bf16* VA, bf16* YB, const float* tabg, float lam, const float* subg, float oml, int tid) {
    const int bh = su >> 2, b = bh >> 3, h = bh & 7, s = su & 3;
    __syncthreads();
    if (tid < 192) { const int rel = 159 - tid; ((LAS float*)(lds + AT_TAB))[tid] = rel < 0 ? -1e30f : (rel < 128 ? tabg[h * 132 + rel] : 0.f); }
    __syncthreads();
    for (int qi = 0; qi < 4; ++qi) {
        const int qb = (qi == 0) ? s : (qi == 1) ? 7 - s : (qi == 2) ? 8 + s : 15 - s;
        dattn_unit(lds, b, h, qb, Q, K, VA, YB, lam, subg, oml, tid);
    }
    __syncthreads();
}

#define RLX_AGENT __ATOMIC_RELAXED, __HIP_MEMORY_SCOPE_AGENT
#define XB_TMO      128
#define XB_XCNT(j)  (256  + 64 * (j))
#define XB_XSUB(j)  (1280 + 64 * (j))
#define XB_XGEN(j)  (2304 + 64 * (j))
#define XB_TOP      3328
#define XB_TOPGEN   3392
#define XCD_BAR_WORDS 3456
#define XB_SPIN_CAP (1u << 18)

__device__ __forceinline__ unsigned xb_ld(unsigned* p)              { return __hip_atomic_load(p, __ATOMIC_RELAXED, __HIP_MEMORY_SCOPE_AGENT); }
__device__ __forceinline__ unsigned xb_add(unsigned* p, unsigned v) { return __hip_atomic_fetch_add(p, v, __ATOMIC_RELAXED, __HIP_MEMORY_SCOPE_AGENT); }
__device__ __forceinline__ unsigned xb_xcc_id() { return (unsigned)__builtin_amdgcn_s_getreg((3 << 11) | 20) & 0xFu; }
#define XB_SPIN(cond, bar) do { unsigned _sp = 0; while (cond) { __builtin_amdgcn_s_sleep(1); \
    if ((++_sp & 255u) == 0u) { if (xb_ld(&(bar)[XB_TMO])) break; if (_sp > XB_SPIN_CAP) { atomicAdd(&(bar)[XB_TMO], 1u); break; } } } } while (0)

struct XcdBarrier {
    unsigned* bar; unsigned x;
    volatile LAS unsigned* st;
};

__device__ __forceinline__ XcdBarrier xcd_barrier_post(unsigned* bar, volatile LAS unsigned* st) {
    XcdBarrier b; b.bar = bar; b.x = xb_xcc_id(); b.st = st;
    if (threadIdx.x == 0) (void)xb_add(&bar[XB_XCNT(b.x)], 1u);
    return b;
}
__device__ __forceinline__ void xcd_barrier_complete(unsigned* bar, unsigned x, unsigned& nloc, unsigned& nx) {
    const unsigned G = gridDim.x * gridDim.y * gridDim.z;
    unsigned sum, cnt, mine, sp = 0u;
    for (;;) {
        sum = 0u; cnt = 0u; mine = 0u;
#pragma unroll
        for (unsigned j = 0; j < 16; ++j) { const unsigned c = xb_ld(&bar[XB_XCNT(j)]); sum += c; cnt += (c > 0u) ? 1u : 0u; mine = (j == x) ? c : mine; }
        if (sum == G) break;
        __builtin_amdgcn_s_sleep(1);
        if ((++sp & 255u) == 0u) { if (xb_ld(&bar[XB_TMO])) break; if (sp > XB_SPIN_CAP) { atomicAdd(&bar[XB_TMO], 1u); break; } }
    }
    nloc = mine > 0u ? mine : 1u; nx = cnt > 0u ? cnt : 1u;
}

__device__ __forceinline__ void xcd_barrier(const XcdBarrier& b) {
    asm volatile("s_waitcnt vmcnt(0)" ::: "memory");
    __syncthreads();
    if (threadIdx.x == 0) {
        unsigned* bar = b.bar;
        __builtin_amdgcn_s_waitcnt(0);
        unsigned nloc = b.st[0], nx = b.st[1];
        if (nloc == 0u) { xcd_barrier_complete(bar, b.x, nloc, nx); b.st[0] = nloc; b.st[1] = nx; }
        const unsigned old = xb_add(&bar[XB_XSUB(b.x)], 1u);
        const unsigned gen = old / nloc;
        if (old + 1u == (gen + 1u) * nloc) {
            __builtin_amdgcn_fence(__ATOMIC_RELEASE, "agent");
            asm volatile("s_waitcnt vmcnt(0)" ::: "memory");
            const unsigned og = xb_add(&bar[XB_TOP], 1u);
            const unsigned tg = og / nx;
            if (og + 1u == (tg + 1u) * nx) xb_add(&bar[XB_TOPGEN], 1u);
            else XB_SPIN(xb_ld(&bar[XB_TOPGEN]) == tg, bar);
            __builtin_amdgcn_fence(__ATOMIC_ACQUIRE, "agent");
            xb_add(&bar[XB_XGEN(b.x)], 1u);
            asm volatile("s_waitcnt vmcnt(0)" ::: "memory");
        } else {
            XB_SPIN(xb_ld(&bar[XB_XGEN(b.x)]) == gen, bar);
            __builtin_amdgcn_fence(__ATOMIC_ACQUIRE, "agent");
            asm volatile("s_waitcnt vmcnt(0)" ::: "memory");
        }
    }
    __syncthreads();
}

constexpr size_t WS_BAR = 32768;
constexpr int BAR_LDS_OFF = 147456 - 64;
struct Args { const float* in[22]; float* out; unsigned char* ws; int ph_lo, ph_hi; };
constexpr int N_PHASES = 2 + 7 * DEPTH;
__global__ void __launch_bounds__(NWAVES * 64, 2) mk_fwd(Args args) {
    extern __shared__ __attribute__((aligned(16))) unsigned char lds_raw[];
    LAS unsigned char* lds = (LAS unsigned char*)lds_raw;
    typedef const __attribute__((address_space(4))) Args* kargs_t;
    if (threadIdx.x < 16) ((LAS unsigned*)(lds + BAR_LDS_OFF))[threadIdx.x] = 0u;
    __syncthreads();
    const XcdBarrier bar = xcd_barrier_post((unsigned*)(args.ws + WS_BAR), (volatile LAS unsigned*)(lds + BAR_LDS_OFF));
    for (int ph = args.ph_lo; ph < args.ph_hi; ++ph) {
        const int tid = mk_tid(), lane = tid & 63, wave = __builtin_amdgcn_readfirstlane(tid >> 6);
        int G = gridDim.x, bx = blockIdx.x; asm volatile("" : "+s"(G), "+s"(bx));
        const int vcu = (G % 8 == 0) ? (bx % 8) * (G / 8) + bx / 8 : bx;
        const int gw = vcu * NWAVES + wave, NGW = G * NWAVES;
        unsigned long long kp_ = (unsigned long long)__builtin_amdgcn_kernarg_segment_ptr(); asm volatile("" : "+s"(kp_));
        const kargs_t ap = (kargs_t)kp_;
        unsigned char* ws = ap->ws;
        const float* x_in = ap->in[0]; float* xo = ap->out;
        bf16* HB = (bf16*)(ws + WS_HB); bf16* VAb = (bf16*)(ws + WS_VA); bf16* Ub = (bf16*)(ws + WS_U); bf16* Vb = (bf16*)(ws + WS_V); bf16* Qb = (bf16*)(ws + WS_Q); bf16* Kb = (bf16*)(ws + WS_K);
        bf16* TMP = (bf16*)(ws + WS_TMP); bf16* ACT = (bf16*)(ws + WS_ACT);
        float* lamw = (float*)(ws + WS_LAM); float* tabw = (float*)(ws + WS_TAB); float* vss = (float*)(ws + WS_VSS);
        if (ph == 0) {
            LAS float* scr = (LAS float*)(lds + wave * 16384);
            constexpr int I_IN = 16 * (NIN / 32), I_G = 16 * (NGATE / 32), I_S = 16 * 32, I_UP = 16 * (NUP / 32), I_DN = (DFF / 64) * 32, I_L = I_IN + I_G + 3 * I_S + I_UP + I_DN;
            for (int it = gw; it < DEPTH * I_L; it += NGW) {
                const int l = it / I_L; int r = it - l * I_L; bf16* wl = (bf16*)(ws + WS_W + (size_t)l * WL_STRIDE);
                if (r < I_IN) { transpose_item(ap->in[2] + (size_t)l * DM * NIN, DM, NIN, (bf16*)((unsigned char*)wl + WO_IN), false, scr, r, lane); continue; } r -= I_IN;
                if (r < I_G) { transpose_item(ap->in[3] + (size_t)l * DM * NGATE, DM, NGATE, (bf16*)((unsigned char*)wl + WO_G), false, scr, r, lane); continue; } r -= I_G;
                if (r < I_S) { transpose_item(ap->in[13] + (size_t)l * DM * DM, DM, DM, (bf16*)((unsigned char*)wl + WO_A), false, scr, r, lane); continue; } r -= I_S;
                if (r < I_S) { transpose_item(ap->in[14] + (size_t)l * DM * DM, DM, DM, (bf16*)((unsigned char*)wl + WO_B), false, scr, r, lane); continue; } r -= I_S;
                if (r < I_S) { transpose_item(ap->in[15] + (size_t)l * DM * DM, DM, DM, (bf16*)((unsigned char*)wl + WO_O), false, scr, r, lane); continue; } r -= I_S;
                if (r < I_UP) { transpose_item(ap->in[17] + (size_t)l * DM * NUP, DM, NUP, (bf16*)((unsigned char*)wl + WO_UP), true, scr, r, lane); continue; } r -= I_UP;
                transpose_item(ap->in[20] + (size_t)l * DFF * DM, DFF, DM, (bf16*)((unsigned char*)wl + WO_DN), false, scr, r, lane);
            }
            for (int m = gw; m < M; m += 4 * NGW) gain_rows4_bf16(x_in, ap->in[1], HB, (float*)(ws + WS_RSS), (size_t)m, (size_t)NGW, lane);
            if (bx == 0) {
                if (wave < DEPTH) { const int l = wave; const float a = wave_sum(ap->in[7][l * 64 + lane] * ap->in[8][l * 64 + lane]), b = wave_sum(ap->in[9][l * 64 + lane] * ap->in[10][l * 64 + lane]);
                    const float lam_init = 0.8f - 0.6f * expf(-0.3f * (float)l);
                    if (lane == 0) lamw[l] = expf(a) - expf(b) + lam_init; }
                for (int e = tid; e < NHEAD * 132; e += NWAVES * 64) { const int h = e / 132, rel = e - h * 132; const float* rb = ap->in[12];
                    tabw[e] = rel < 128 ? (rb[t5_bucket(rel) * NHEAD + h] - rb[31 * NHEAD + h]) * 1.4426950408889634f : 0.f; }
            }
        } else if (ph == N_PHASES - 1) {
            if (M % (4 * NGW) == 0) { for (int m = gw; m < M; m += 4 * NGW) norm_rows4_f32(xo, ap->in[21], (size_t)m, (size_t)NGW, lane); }
            else for (int m = gw; m < M; m += NGW) norm_row_f32(xo + (size_t)m * DM, ap->in[21], lane);
        } else {
            const int l = (ph - 1) / 7, k = (ph - 1) % 7;
            unsigned char* wl = ws + WS_W + (size_t)l * WL_STRIDE; float* rss = (float*)(ws + WS_RSS);
            if (k == 0) {
                pg8::Gemm g{HB, (const bf16*)(wl + WO_IN), M, NIN, DM}; pg8::StaticOrder S; S.init(M / 256, NIN / 256, G, bx);
                pg8::EpiIn E{Ub, (size_t)(WS_V - WS_U) / 2, VAb, vss, QSCALE, rss};
                pg8::gemm_phase<pg8::EpiIn, pg8::StaticOrder, true, true>(lds, g, S, E);
            } else if (k == 1) {
                const float* gv = ap->in[4] + l * DM; const float* wsl = ap->in[5] + (size_t)l * 8 * 128 * 128; const float* bl = ap->in[6] + l * 8 * 128;
                gmlp_phase(lds, vcu, G, Vb, Ub, vss, gv, wsl, bl, tid);
                const float lam = lamw[l]; const float oml = 1.0f - (0.8f - 0.6f * expf(-0.3f * (float)l));
                for (int su = vcu; su < 256; su += G) attn_super(lds, su, Qb, Kb, VAb, Qb, tabw, lam, ap->in[11] + l * 128, oml, tid);
            } else if (k == 2) {
                pg8::Gemm g{HB, (const bf16*)(wl + WO_G), M, NGATE, DM}; pg8::StaticOrder S; S.init(M / 256, NGATE / 256, G, bx);
                pg8::EpiGate E{Vb, Kb, rss};
                pg8::gemm_phase<pg8::EpiGate, pg8::StaticOrder, true, true>(lds, g, S, E);
            } else if (k == 3) {
                { pg8::Gemm g{Ub, (const bf16*)(wl + WO_A), M, DM, DM}; pg8::StaticOrder S; S.init(M / 256, DM / 256, G, bx);
                  pg8::EpiMerge<0> E{Vb, TMP, nullptr};
                  pg8::gemm_phase<pg8::EpiMerge<0>, pg8::StaticOrder, true, true>(lds, g, S, E); }
                { pg8::Gemm g{Qb, (const bf16*)(wl + WO_B), M, DM, DM}; pg8::StaticOrder S; S.init(M / 256, DM / 256, G, bx);
                  pg8::EpiMerge<1> E{Kb, TMP, VAb};
                  pg8::gemm_phase<pg8::EpiMerge<1>, pg8::StaticOrder, true, true>(lds, g, S, E); }
            } else if (k == 4 || k == 6) {
                pg8::Gemm g{k == 4 ? VAb : ACT, (const bf16*)(wl + (k == 4 ? WO_O : WO_DN)), M, DM, k == 4 ? DM : DFF}; pg8::StaticOrder S; S.init(M / 256, DM / 256, G, bx);
                const bool leave = (k == 4) || (l + 1 < DEPTH);
                pg8::EpiRes E{(l == 0 && k == 4) ? x_in : xo, xo, leave ? HB : nullptr, k == 4 ? ap->in[16] + l * DM : ap->in[1] + (l + 1 < DEPTH ? l + 1 : l) * DM, rss};
                pg8::gemm_phase<pg8::EpiRes, pg8::StaticOrder, true, true>(lds, g, S, E);
            } else {
                pg8::Gemm g{HB, (const bf16*)(wl + WO_UP), M, NUP, DM}; pg8::StaticOrder S; S.init(BATCH * 17, NUP / 256, G, bx, 1);
                pg8::EpiUp E{ACT, ap->in[18] + (size_t)l * 3 * DFF, ap->in[19] + (size_t)l * DFF, (LAS float*)(lds + HALO_OFF), rss};
                pg8::gemm_phase<pg8::EpiUp, pg8::StaticOrder, true, true>(lds, g, S, E);
            }
        }
        if (ph + 1 < args.ph_hi) { if (ph < 0) cg::this_grid().sync(); else xcd_barrier(bar); }
    }
}

extern "C" void kernel_launch(void* const* d_in, const int* in_sizes, int n_in, void* d_out, int out_size, void* d_ws, size_t ws_size, hipStream_t stream) {
    static int grid = 0;
    if (grid == 0) {
        if (n_in != 22 || out_size != M * DM || ws_size < WS_END) { fprintf(stderr, "kernel_launch: unexpected shapes (n_in %d out %d ws %zu)\n", n_in, out_size, ws_size); grid = -1; return; }
        int dev = 0, cus = 0, per_cu = 0;
        if (hipGetDevice(&dev) != hipSuccess || hipDeviceGetAttribute(&cus, hipDeviceAttributeMultiprocessorCount, dev) != hipSuccess) { grid = -1; return; }
        if (hipFuncSetAttribute((const void*)mk_fwd, hipFuncAttributeMaxDynamicSharedMemorySize, LDS_BYTES) != hipSuccess) { fprintf(stderr, "kernel_launch: hipFuncSetAttribute failed\n"); grid = -1; return; }
        if (hipOccupancyMaxActiveBlocksPerMultiprocessor(&per_cu, (const void*)mk_fwd, NWAVES * 64, LDS_BYTES) != hipSuccess || per_cu < 1) { fprintf(stderr, "kernel_launch: occupancy query gave %d\n", per_cu); per_cu = 1; }
        (void)hipGetLastError();
        grid = cus;
    }
    if (grid < 0) return;
    if (hipMemsetAsync((char*)d_ws + WS_BAR, 0, 16384, stream) != hipSuccess) { fprintf(stderr, "kernel_launch: hipMemsetAsync failed\n"); return; }
    Args a{};
    for (int i = 0; i < 22; ++i) a.in[i] = (const float*)d_in[i];
    a.out = (float*)d_out; a.ws = (unsigned char*)d_ws;
#if MK_SINGLE
    a.ph_lo = 0; a.ph_hi = N_PHASES;
    void* kargs[] = {&a};
    const hipError_t e = hipLaunchCooperativeKernel((const void*)mk_fwd, dim3(grid), dim3(NWAVES * 64), kargs, LDS_BYTES, stream);
    if (e != hipSuccess) fprintf(stderr, "kernel_launch: cooperative launch failed: %s (grid %d)\n", hipGetErrorString(e), grid);
#else
    for (int p = 0; p < N_PHASES; ++p) { a.ph_lo = p; a.ph_hi = p + 1; hipLaunchKernelGGL(mk_fwd, dim3(grid), dim3(NWAVES * 64), LDS_BYTES, stream, a); }
#endif
}
```

```cpp
#include <hip/hip_runtime.h>
#include <hip/hip_cooperative_groups.h>
#include <hip/hip_bf16.h>
#include <cstdio>
#include <cstdint>
#include <cmath>
namespace cg = cooperative_groups;
#ifndef MK_SINGLE
#define MK_SINGLE 1
#endif
__device__ __forceinline__ int mk_tid() { int t = threadIdx.x; asm volatile("" : "+v"(t)); return t; }
namespace pg8 {
#define PG8_LAS __attribute__((address_space(3)))
typedef unsigned short bf16_t;
typedef short bf16x8 __attribute__((ext_vector_type(8)));
typedef float f32x4 __attribute__((ext_vector_type(4)));
typedef unsigned u32x4 __attribute__((ext_vector_type(4)));
constexpr int BM = 256, BK = 64, HALF = 128, HTB = HALF * BK * 2  , STAGE_BYTES = 8 * HTB, NXCD = 8, WGM = 8;

__host__ __device__ __forceinline__ int lds_byte(int r, int c) { const int st = (r >> 4) * 2 + (c >> 5), rr = r & 15, cc = c & 31, ob = rr * 64 + cc * 2; return st * 1024 + (ob ^ (((ob >> 9) & 1) << 5)); }
__host__ __device__ __forceinline__ void stage_rc(int b, int& R, int& C) { const int st = b / 1024, sb = b % 1024, swz = sb ^ (((sb >> 9) & 1) << 5); R = (st >> 1) * 16 + swz / 64; C = (st & 1) * 32 + (swz % 64) / 2; }
__host__ __device__ __forceinline__ int perm32(int rho) { const int n = rho >> 4, i = rho & 15; return 8 * (i >> 2) + 4 * n + (i & 3); }

struct Unit { int pm, pn; };
struct Gemm { const bf16_t* A; const bf16_t* Bt; int M, N, K; };

struct StaticOrder {
    int nM, nN, nwg, G, c;
    int amode;
    __host__ __device__ void init(int nM_, int nN_, int G_, int c_, int amode_ = 0) { nM = nM_; nN = nN_; nwg = nM * nN; G = G_; c = c_; amode = amode_; }
    __device__ __forceinline__ long a_byte(const Unit& u, int K) const { const long row = amode ? (long)((u.pm / 17) * 4096 + (u.pm % 17) * 254 - 2) : (long)u.pm * BM; return row * (long)K * 2; }
    __host__ __device__ bool next(int i, Unit& u) const {
        const long L = (long)i * G + c; if (L >= nwg) return false;
        int wgid = (int)L; { const int q = nwg / NXCD, r = nwg % NXCD, xcd = wgid % NXCD, off = wgid / NXCD; wgid = (xcd < r ? xcd * (q + 1) : r * (q + 1) + (xcd - r) * q) + off; }
        const int nig = WGM * nN, gid = wgid / nig, fm = gid * WGM, gsz = (nM - fm) < WGM ? (nM - fm) : WGM;
        u.pm = fm + ((wgid % nig) % gsz); u.pn = (wgid % nig) / gsz; return true;
    }
    __device__ __forceinline__ void a_ready(const Unit&) const {}
    __device__ __forceinline__ void done(const Unit&) const {}
};

typedef float f32x2_t __attribute__((ext_vector_type(2))); typedef __bf16 bf16x2_t __attribute__((ext_vector_type(2)));
__device__ __forceinline__ unsigned cvt_pk_bf16(float lo, float hi) { f32x2_t v = {lo, hi}; bf16x2_t b = __builtin_convertvector(v, bf16x2_t); return __builtin_bit_cast(unsigned, b); }
__device__ __forceinline__ float bf_lo(unsigned w) { return __uint_as_float(w << 16); }
__device__ __forceinline__ float bf_hi(unsigned w) { return __uint_as_float(w & 0xffff0000u); }
__device__ __forceinline__ float gelu_t(float x) {
    const float u = x * (0.7978845608f + 0.0356774081f * x * x);
    const float e = __builtin_amdgcn_exp2f(-2.8853900818f * u);
    return x * __builtin_amdgcn_rcpf(1.0f + e);
}
__device__ __forceinline__ float sigmoid_f(float x) { return __builtin_amdgcn_rcpf(1.0f + __builtin_amdgcn_exp2f(-1.4426950409f * x)); }
__device__ __forceinline__ u32x4 pack8(const f32x4& v0, const f32x4& v1) { u32x4 w; w.x = cvt_pk_bf16(v0[0], v0[1]); w.y = cvt_pk_bf16(v0[2], v0[3]); w.z = cvt_pk_bf16(v1[0], v1[1]); w.w = cvt_pk_bf16(v1[2], v1[3]); return w; }

__device__ __forceinline__ float row_rstd(const float* rss, long row, int fq) {
    const f32x4 p = *(const f32x4*)(rss + row * 16 + fq * 4); float s = (p[0] + p[1]) + (p[2] + p[3]); s += __shfl_xor(s, 16); s += __shfl_xor(s, 32);
    return rsqrtf(s * (1.0f / 1024.0f) + 1e-6f);
}
struct EpiIn {
    static constexpr bool PERM = true, AFTER_DRAIN = false;
    bf16_t* O0; size_t stride; bf16_t* O4; float* vss; float qscale; const float* rss;
    __device__ __forceinline__ void operator()(const f32x4 (&acc)[2][2][4][2], const Unit& u, int wr, int wc, int fr, int fq) const {
        const int t = u.pn >> 2, row0 = u.pm * BM + wr * 64 + fr, col0 = (u.pn & 3) * BM + wc * 32 + 8 * fq;
        bf16_t* base = (t == 4) ? O4 : O0 + (size_t)t * stride;
        const float sc = (t == 2) ? qscale : 1.f;
#pragma unroll
        for (int ai = 0; ai < 2; ++ai)
#pragma unroll
            for (int m = 0; m < 4; ++m) { const int row = row0 + ai * HALF + m * 16; bf16_t* rowp = base + (size_t)row * 1024 + col0; float ss = 0.f; const float rn = row_rstd(rss, row, fq);
#pragma unroll
                for (int bj = 0; bj < 2; ++bj) { f32x4 v0 = acc[ai][bj][m][0] * rn, v1 = acc[ai][bj][m][1] * rn;
                    if (t <= 1) {
#pragma unroll
                        for (int j = 0; j < 4; ++j) { v0[j] = gelu_t(v0[j]); v1[j] = gelu_t(v1[j]); }
#pragma unroll
                        for (int j = 0; j < 4; ++j) ss += v0[j] * v0[j] + v1[j] * v1[j];
                    }
                    v0 = v0 * sc; v1 = v1 * sc;
                    *(u32x4*)(rowp + bj * HALF) = pack8(v0, v1); }
                if (t == 1) { ss += __shfl_xor(ss, 16); ss += __shfl_xor(ss, 32); if (fq == 0) vss[(size_t)row * 16 + (u.pn & 3) * 4 + wc] = ss; } }
    }
};
struct EpiGate {
    static constexpr bool PERM = true, AFTER_DRAIN = false;
    bf16_t* GA; bf16_t* GB; const float* rss;
    __device__ __forceinline__ void operator()(const f32x4 (&acc)[2][2][4][2], const Unit& u, int wr, int wc, int fr, int fq) const {
        const int t = u.pn >> 2, row0 = u.pm * BM + wr * 64 + fr, col0 = (u.pn & 3) * BM + wc * 32 + 8 * fq;
        bf16_t* base = t ? GB : GA;
#pragma unroll
        for (int ai = 0; ai < 2; ++ai)
#pragma unroll
            for (int m = 0; m < 4; ++m) { bf16_t* rowp = base + (size_t)(row0 + ai * HALF + m * 16) * 1024 + col0; const float rn = row_rstd(rss, row0 + ai * HALF + m * 16, fq);
#pragma unroll
                for (int bj = 0; bj < 2; ++bj) { f32x4 v0 = acc[ai][bj][m][0] * rn, v1 = acc[ai][bj][m][1] * rn;
#pragma unroll
                    for (int j = 0; j < 4; ++j) { v0[j] = sigmoid_f(v0[j]); v1[j] = sigmoid_f(v1[j]); }
                    *(u32x4*)(rowp + bj * HALF) = pack8(v0, v1); } }
    }
};
template <int SECOND> struct EpiMerge {
    static constexpr bool PERM = true, AFTER_DRAIN = false;
    const bf16_t* G; bf16_t* T; bf16_t* MG;
    __device__ __forceinline__ void operator()(const f32x4 (&acc)[2][2][4][2], const Unit& u, int wr, int wc, int fr, int fq) const {
        const int row0 = u.pm * BM + wr * 64 + fr, col0 = u.pn * BM + wc * 32 + 8 * fq;
#pragma unroll
        for (int ai = 0; ai < 2; ++ai) {
            u32x4 gpre[4][2], tpre[4][2];
#pragma unroll
            for (int m = 0; m < 4; ++m)
#pragma unroll
                for (int bj = 0; bj < 2; ++bj) { const size_t off = (size_t)(row0 + ai * HALF + m * 16) * 1024 + col0 + bj * HALF; gpre[m][bj] = *(const u32x4*)(G + off); if (SECOND) tpre[m][bj] = *(const u32x4*)(T + off); }
#pragma unroll
            for (int m = 0; m < 4; ++m) { const size_t off = (size_t)(row0 + ai * HALF + m * 16) * 1024 + col0;
#pragma unroll
                for (int bj = 0; bj < 2; ++bj) { const u32x4 gw = gpre[m][bj];
                    f32x4 g0 = {bf_lo(gw.x), bf_hi(gw.x), bf_lo(gw.y), bf_hi(gw.y)}, g1 = {bf_lo(gw.z), bf_hi(gw.z), bf_lo(gw.w), bf_hi(gw.w)};
                    f32x4 v0 = acc[ai][bj][m][0] * g0, v1 = acc[ai][bj][m][1] * g1;
                    bf16_t* tp = T + off + bj * HALF;
                    if (SECOND) { const u32x4 tw = tpre[m][bj]; v0 += (f32x4){bf_lo(tw.x), bf_hi(tw.x), bf_lo(tw.y), bf_hi(tw.y)}; v1 += (f32x4){bf_lo(tw.z), bf_hi(tw.z), bf_lo(tw.w), bf_hi(tw.w)};
                        *(u32x4*)(MG + off + bj * HALF) = pack8(v0, v1); }
                    else { *(u32x4*)tp = pack8(v0, v1); } } }
        }
    }
};
struct EpiRes {
    static constexpr bool PERM = true, AFTER_DRAIN = false;
    const float* base; float* out; bf16_t* XG; const float* gn; float* rss;
    __device__ __forceinline__ void operator()(const f32x4 (&acc)[2][2][4][2], const Unit& u, int wr, int wc, int fr, int fq) const {
        const int row0 = u.pm * BM + wr * 64 + fr, col0 = u.pn * BM + wc * 32 + 8 * fq;
        f32x4 g0[2], g1[2];
        if (XG) {
#pragma unroll
            for (int bj = 0; bj < 2; ++bj) { g0[bj] = *(const f32x4*)(gn + col0 + bj * HALF); g1[bj] = *(const f32x4*)(gn + col0 + bj * HALF + 4); } }
#pragma unroll
        for (int ai = 0; ai < 2; ++ai) {
            f32x4 bpre[4][2][2];
#pragma unroll
            for (int m = 0; m < 4; ++m)
#pragma unroll
                for (int bj = 0; bj < 2; ++bj) { const float* bp = base + (size_t)(row0 + ai * HALF + m * 16) * 1024 + col0 + bj * HALF; bpre[m][bj][0] = *(const f32x4*)bp; bpre[m][bj][1] = *(const f32x4*)(bp + 4); }
#pragma unroll
            for (int m = 0; m < 4; ++m) { const int row = row0 + ai * HALF + m * 16; const size_t off = (size_t)row * 1024 + col0; float ss = 0.f;
#pragma unroll
                for (int bj = 0; bj < 2; ++bj) { float* op = out + off + bj * HALF;
                    const f32x4 x0 = bpre[m][bj][0] + acc[ai][bj][m][0], x1 = bpre[m][bj][1] + acc[ai][bj][m][1];
                    *(f32x4*)op = x0; *(f32x4*)(op + 4) = x1;
                    if (XG) { ss += ((x0[0] * x0[0] + x0[1] * x0[1]) + (x0[2] * x0[2] + x0[3] * x0[3])) + ((x1[0] * x1[0] + x1[1] * x1[1]) + (x1[2] * x1[2] + x1[3] * x1[3]));
                        *(u32x4*)(XG + off + bj * HALF) = pack8(x0 * g0[bj], x1 * g1[bj]); } }
                if (XG) { ss += __shfl_xor(ss, 16); ss += __shfl_xor(ss, 32); if (fq == 0) rss[(size_t)row * 16 + u.pn * 4 + wc] = ss; } }
        }
    }
};
__device__ __forceinline__ float dpp_ror1(float v) { return __int_as_float(__builtin_amdgcn_update_dpp(0, __float_as_int(v), 0x121, 0xf, 0xf, false)); }
__device__ __forceinline__ float dpp_ror2(float v) { return __int_as_float(__builtin_amdgcn_update_dpp(0, __float_as_int(v), 0x122, 0xf, 0xf, false)); }
struct EpiUp {
    static constexpr bool PERM = true, AFTER_DRAIN = false;
    bf16_t* ACT; const float* cw; const float* cb; PG8_LAS float* halo; const float* rss;
    __device__ __forceinline__ void operator()(const f32x4 (&acc)[2][2][4][2], const Unit& u, int wr, int wc, int fr, int fq) const {
        const int b = u.pm / 17, i = u.pm - b * 17, fl = wc * 32 + 8 * fq, f0 = u.pn * 128 + fl;
        float rn[2][4];
#pragma unroll
        for (int ai = 0; ai < 2; ++ai)
#pragma unroll
            for (int m = 0; m < 4; ++m) rn[ai][m] = row_rstd(rss, (long)b * 4096 + 254 * i - 2 + ai * HALF + wr * 64 + m * 16 + fr, fq);
        if (fr >= 14) {
#pragma unroll
            for (int ai = 0; ai < 2; ++ai)
#pragma unroll
                for (int n = 0; n < 2; ++n) *(PG8_LAS f32x4*)(halo + ((ai * 2 + wr) * 2 + (fr - 14)) * 128 + fl + 4 * n) = acc[ai][0][3][n] * rn[ai][3];
        }
        asm volatile("s_waitcnt lgkmcnt(0)" ::: "memory"); __builtin_amdgcn_s_barrier(); asm volatile("" ::: "memory");
        f32x4 w0[2], w1[2], w2[2], bb[2];
#pragma unroll
        for (int n = 0; n < 2; ++n) { w0[n] = *(const f32x4*)(cw + f0 + 4 * n); w1[n] = *(const f32x4*)(cw + 2816 + f0 + 4 * n); w2[n] = *(const f32x4*)(cw + 2 * 2816 + f0 + 4 * n); bb[n] = *(const f32x4*)(cb + f0 + 4 * n); }
#pragma unroll
        for (int ai = 0; ai < 2; ++ai) {
            const int blk = ai * 2 + wr;
            f32x4 pc1[2], pc2[2];
#pragma unroll
            for (int n = 0; n < 2; ++n) { f32x4 hv = {0.f, 0.f, 0.f, 0.f};
                if (blk > 0 && fr >= 14) hv = *(const PG8_LAS f32x4*)(halo + ((blk - 1) * 2 + (fr - 14)) * 128 + fl + 4 * n);
#pragma unroll
                for (int j = 0; j < 4; ++j) { pc1[n][j] = dpp_ror1(hv[j]); pc2[n][j] = dpp_ror2(hv[j]); } }
#pragma unroll
            for (int m = 0; m < 4; ++m) { const int r = ai * HALF + wr * 64 + m * 16 + fr, tk = 254 * i - 2 + r;
                f32x4 o[2];
#pragma unroll
                for (int n = 0; n < 2; ++n) { f32x4 cur = acc[ai][0][m][n] * rn[ai][m]; if (tk < 0) cur = (f32x4){0.f, 0.f, 0.f, 0.f};
#pragma unroll
                    for (int j = 0; j < 4; ++j) { const float c1 = dpp_ror1(cur[j]), c2 = dpp_ror2(cur[j]);
                        const float p1 = fr >= 1 ? c1 : pc1[n][j], p2 = fr >= 2 ? c2 : pc2[n][j]; pc1[n][j] = c1; pc2[n][j] = c2;
                        const float cv = bb[n][j] + w0[n][j] * p2 + w1[n][j] * p1 + w2[n][j] * cur[j];
                        o[n][j] = gelu_t(cv) * (acc[ai][1][m][n][j] * rn[ai][m]); } }
                if (r >= 2 && tk < 4096) *(u32x4*)(ACT + (size_t)(b * 4096 + tk) * 2816 + f0) = pack8(o[0], o[1]); }
        }
    }
};

template <class Epi, class Sched, bool ALIGN_EPI = false, bool SP2 = false>
__device__ __forceinline__ void gemm_phase(PG8_LAS unsigned char* lds, const Gemm g, const Sched& S, const Epi& E) {
    const int tid = mk_tid(), wid = __builtin_amdgcn_readfirstlane(tid >> 6), lane = tid & 63, wr = wid >> 2, wc = wid & 3, fr = lane & 15, fq = lane >> 4;
    const int K = g.K, nt = K / BK;
    unsigned voffA[2], voffB[2];
#pragma unroll
    for (int i = 0; i < 2; ++i) { int R, C; stage_rc(tid * 16 + i * 8192, R, C); const int Rb = Epi::PERM ? ((R & ~31) + perm32(R & 31)) : R;
        voffA[i] = (unsigned)(R * K + C) * 2u; voffB[i] = (unsigned)(Rb * K + C) * 2u; }
    const size_t kstep = (size_t)(BK * 2);
    const size_t hstep = (size_t)HALF * K * 2;
    const size_t tstep = 2 * hstep;
    const unsigned ldsw = (unsigned)wid * 1024u;
    const int aoff = lds_byte(wr * 64 + fr, fq * 8), boff = lds_byte(wc * 32 + fr, fq * 8);
#define PG8_SA(b, h) (((b) * 2 + (h)) * HTB)
#define PG8_SB(b, h) ((4 + (b) * 2 + (h)) * HTB)
#define PG8_STAGE(bufoff, gbase, voff) do { _Pragma("unroll") for (int _i = 0; _i < 2; ++_i) \
        __builtin_amdgcn_global_load_lds((const unsigned*)((const char*)(gbase) + (voff)[_i]), (PG8_LAS unsigned*)(lds + (bufoff) + ldsw + _i * 8192), 16, 0, 0); } while (0)
#define PG8_LDA(dst, b, h) do { _Pragma("unroll") for (int m = 0; m < 4; ++m) _Pragma("unroll") for (int k = 0; k < 2; ++k) dst[m][k] = *(const PG8_LAS bf16x8*)(lds + PG8_SA(b, h) + aoff + m * 2048 + k * 1024); } while (0)
#define PG8_LDB(dst, b, h) do { _Pragma("unroll") for (int n = 0; n < 2; ++n) _Pragma("unroll") for (int k = 0; k < 2; ++k) dst[n][k] = *(const PG8_LAS bf16x8*)(lds + PG8_SB(b, h) + boff + n * 2048 + k * 1024); } while (0)
#define PG8_MMA(ai, bj, At, Bt) do { __builtin_amdgcn_s_setprio(1); _Pragma("unroll") for (int m = 0; m < 4; ++m) _Pragma("unroll") for (int n = 0; n < 2; ++n) _Pragma("unroll") for (int k = 0; k < 2; ++k) \
        acc[ai][bj][m][n] = __builtin_amdgcn_mfma_f32_16x16x32_bf16(Bt[n][k], At[m][k], acc[ai][bj][m][n], 0, 0, 0); __builtin_amdgcn_s_setprio(0); } while (0)
#define PG8_WAIT_V(n) asm volatile("s_waitcnt vmcnt(" #n ")" ::: "memory")
#define PG8_WAIT_L(n) asm volatile("s_waitcnt lgkmcnt(" #n ")" ::: "memory")
#define PG8_BAR __builtin_amdgcn_s_barrier()
#define PG8_SCHED __builtin_amdgcn_sched_barrier(0)
    Unit cur, nxt; int ui = 0;
    if (!S.next(0, cur)) return;
    f32x4 acc[2][2][4][2];
#pragma unroll
    for (int a = 0; a < 2; ++a)
#pragma unroll
        for (int b = 0; b < 2; ++b)
#pragma unroll
            for (int m = 0; m < 4; ++m)
#pragma unroll
                for (int n = 0; n < 2; ++n) acc[a][b][m][n] = (f32x4){0.f, 0.f, 0.f, 0.f};
    bf16x8 At[4][2], B0[2][2], B1[2][2];
    const char* cA = (const char*)g.A + S.a_byte(cur, K); const char* cB = (const char*)g.Bt + (size_t)cur.pn * tstep;
    S.a_ready(cur);
    if constexpr (SP2) {
        PG8_STAGE(PG8_SB(0, 0), cB, voffB); PG8_STAGE(PG8_SB(0, 1), cB + hstep, voffB); PG8_STAGE(PG8_SA(0, 0), cA, voffA); PG8_STAGE(PG8_SA(0, 1), cA + hstep, voffA);
        if (wr == 1) PG8_BAR;
        PG8_WAIT_V(2); PG8_BAR;
        PG8_STAGE(PG8_SB(1, 0), cB + kstep, voffB); PG8_STAGE(PG8_SA(1, 0), cA + kstep, voffA); PG8_STAGE(PG8_SB(1, 1), cB + hstep + kstep, voffB);
        PG8_WAIT_V(6); PG8_BAR;
    } else {
        PG8_STAGE(PG8_SB(0, 0), cB, voffB); PG8_STAGE(PG8_SA(0, 0), cA, voffA); PG8_STAGE(PG8_SB(0, 1), cB + hstep, voffB); PG8_STAGE(PG8_SA(0, 1), cA + hstep, voffA);
        if (wr == 1) PG8_BAR;
        PG8_WAIT_V(4); PG8_BAR;
        PG8_STAGE(PG8_SB(1, 0), cB + kstep, voffB); PG8_STAGE(PG8_SA(1, 0), cA + kstep, voffA); PG8_STAGE(PG8_SB(1, 1), cB + hstep + kstep, voffB);
        PG8_WAIT_V(6); PG8_BAR;
    }
    for (;;) {
        const bool has_next = S.next(ui + 1, nxt);
        const char* nA = has_next ? (const char*)g.A + S.a_byte(nxt, K) : cA; const char* nB = has_next ? (const char*)g.Bt + (size_t)nxt.pn * tstep : cB;
        for (int t = 0; t < nt; t += 2) {
            const bool last = (t == nt - 2);
            const char* a1 = cA + (size_t)(t + 1) * kstep;
            const char* a2 = last ? nA : cA + (size_t)(t + 2) * kstep; const char* b2 = last ? nB : cB + (size_t)(t + 2) * kstep;
            const char* a3 = a2 + kstep; const char* b3 = b2 + kstep;
            if (last && has_next) S.a_ready(nxt);
            if constexpr (SP2) {
            PG8_LDB(B0, 0, 0); PG8_LDB(B1, 0, 1); PG8_SCHED; PG8_LDA(At, 0, 0); PG8_STAGE(PG8_SA(1, 1), a1 + hstep, voffA);
            PG8_WAIT_V(8); PG8_WAIT_L(0); PG8_BAR; PG8_MMA(0, 0, At, B0); PG8_MMA(0, 1, At, B1); PG8_BAR; PG8_SCHED;
            PG8_LDA(At, 0, 1); PG8_STAGE(PG8_SB(0, 0), b2, voffB); PG8_STAGE(PG8_SB(0, 1), b2 + hstep, voffB); PG8_STAGE(PG8_SA(0, 0), a2, voffA);
            PG8_WAIT_V(8); PG8_WAIT_L(0); PG8_BAR; PG8_MMA(1, 0, At, B0); PG8_MMA(1, 1, At, B1); PG8_BAR; PG8_SCHED;
            PG8_LDB(B0, 1, 0); PG8_LDB(B1, 1, 1); PG8_SCHED; PG8_LDA(At, 1, 0); PG8_STAGE(PG8_SA(0, 1), a2 + hstep, voffA);
            PG8_WAIT_V(8); PG8_WAIT_L(0); PG8_BAR; PG8_MMA(0, 0, At, B0); PG8_MMA(0, 1, At, B1); PG8_BAR; PG8_SCHED;
            PG8_LDA(At, 1, 1); PG8_STAGE(PG8_SB(1, 0), b3, voffB); PG8_STAGE(PG8_SB(1, 1), b3 + hstep, voffB); PG8_STAGE(PG8_SA(1, 0), a3, voffA);
            PG8_WAIT_V(8); PG8_WAIT_L(0); PG8_BAR; PG8_MMA(1, 0, At, B0); PG8_MMA(1, 1, At, B1); PG8_BAR; PG8_SCHED;
            } else {
            PG8_LDB(B0, 0, 0); PG8_SCHED; PG8_LDA(At, 0, 0); PG8_STAGE(PG8_SA(1, 1), a1 + hstep, voffA);
            PG8_WAIT_L(8); PG8_BAR; PG8_WAIT_L(0); PG8_MMA(0, 0, At, B0); PG8_BAR; PG8_SCHED;
            PG8_LDB(B1, 0, 1); PG8_STAGE(PG8_SB(0, 0), b2, voffB);
            PG8_BAR; PG8_WAIT_L(0); PG8_MMA(0, 1, At, B1); PG8_BAR;
            PG8_LDA(At, 0, 1); PG8_STAGE(PG8_SA(0, 0), a2, voffA);
            PG8_BAR; PG8_WAIT_L(0); PG8_MMA(1, 0, At, B0); PG8_BAR; PG8_SCHED;
            PG8_STAGE(PG8_SB(0, 1), b2 + hstep, voffB);
            PG8_WAIT_V(6); PG8_BAR; PG8_MMA(1, 1, At, B1); PG8_BAR;
            PG8_LDB(B0, 1, 0); PG8_SCHED; PG8_LDA(At, 1, 0); PG8_STAGE(PG8_SA(0, 1), a2 + hstep, voffA);
            PG8_WAIT_L(8); PG8_BAR; PG8_WAIT_L(0); PG8_MMA(0, 0, At, B0); PG8_BAR; PG8_SCHED;
            PG8_LDB(B1, 1, 1); PG8_STAGE(PG8_SB(1, 0), b3, voffB);
            PG8_BAR; PG8_WAIT_L(0); PG8_MMA(0, 1, At, B1); PG8_BAR;
            PG8_LDA(At, 1, 1); PG8_STAGE(PG8_SA(1, 0), a3, voffA);
            PG8_BAR; PG8_WAIT_L(0); PG8_MMA(1, 0, At, B0); PG8_BAR; PG8_SCHED;
            PG8_STAGE(PG8_SB(1, 1), b3 + hstep, voffB);
            PG8_WAIT_V(6); PG8_BAR; PG8_MMA(1, 1, At, B1); PG8_BAR;
            }
        }
        if constexpr (ALIGN_EPI) { if (wr == 0) PG8_BAR; }
        if constexpr (!Epi::AFTER_DRAIN) { E(acc, cur, wr, wc, fr, fq); S.done(cur); }
        if (!has_next) break;
#pragma unroll
        for (int a = 0; a < 2; ++a)
#pragma unroll
            for (int b = 0; b < 2; ++b)
#pragma unroll
                for (int m = 0; m < 4; ++m)
#pragma unroll
                    for (int n = 0; n < 2; ++n) acc[a][b][m][n] = (f32x4){0.f, 0.f, 0.f, 0.f};
        cur = nxt; cA = nA; cB = nB; ++ui;
        if constexpr (ALIGN_EPI) { if (wr == 1) PG8_BAR; }
    }
    PG8_WAIT_V(0);
    if constexpr (!ALIGN_EPI) { if (wr == 0) PG8_BAR; }
    PG8_BAR;
    if constexpr (Epi::AFTER_DRAIN) { E.fused(acc, cur, wr, wc, fr, fq, lds, wid, lane); S.done(cur); }
#undef PG8_SA
#undef PG8_SB
#undef PG8_STAGE
#undef PG8_LDA
#undef PG8_LDB
#undef PG8_MMA
#undef PG8_WAIT_V
#undef PG8_WAIT_L
#undef PG8_BAR
#undef PG8_SCHED
}
}

#define GAS __attribute__((address_space(1)))
#define LAS __attribute__((address_space(3)))
typedef unsigned short bf16;
typedef unsigned v4u __attribute__((ext_vector_type(4)));
typedef unsigned v2u __attribute__((ext_vector_type(2)));
typedef float f32x4 __attribute__((ext_vector_type(4)));
typedef short bf16x8 __attribute__((ext_vector_type(8)));
typedef float f32x16 __attribute__((ext_vector_type(16)));
#define LDS_WAIT() asm volatile("s_waitcnt lgkmcnt(0)" ::: "memory")
#define VM_WAIT() asm volatile("s_waitcnt vmcnt(0)" ::: "memory")
__device__ __forceinline__ unsigned f2bf(float f) { unsigned u = __builtin_bit_cast(unsigned, f); return (u + 0x7fffu + ((u >> 16) & 1u)) >> 16; }
__device__ __forceinline__ unsigned pk2(float lo, float hi) { return f2bf(lo) | (f2bf(hi) << 16); }
__device__ __forceinline__ float bflo(unsigned w) { return __uint_as_float(w << 16); }
__device__ __forceinline__ float bfhi(unsigned w) { return __uint_as_float(w & 0xffff0000u); }

constexpr int NWAVES = 8;
constexpr int BATCH = 8, SEQ = 4096, DM = 1024, M = BATCH * SEQ, NIN = 5120, NGATE = 2048, DFF = 2816, NUP = 2 * DFF, DEPTH = 2, NHEAD = 8;
constexpr float EPS = 1e-6f;
constexpr float QSCALE = 0.125f * 1.4426950408889634f;
constexpr size_t MiB = 1u << 20;
constexpr size_t WS_LAM = 0, WS_TAB = 4096, WS_VSS = 1 * MiB;
constexpr size_t WS_W = 4 * MiB, WL_STRIDE = 38273024;
constexpr size_t WO_IN = 0, WO_G = 10 * MiB, WO_A = 14 * MiB, WO_B = 16 * MiB, WO_O = 18 * MiB, WO_UP = 20 * MiB, WO_DN = 31 * MiB;
constexpr size_t WS_RSS = 78 * MiB;
constexpr size_t WS_HB = 112 * MiB, WS_VA = 176 * MiB, WS_U = 240 * MiB, WS_V = 304 * MiB, WS_Q = 368 * MiB, WS_K = 432 * MiB;
constexpr size_t WS_TMP = WS_HB;
constexpr size_t WS_YA = WS_U, WS_MG = WS_U, WS_GA = WS_V, WS_YB = WS_Q, WS_GB = WS_K;
constexpr size_t WS_ACT = WS_U;
constexpr size_t WS_END = 496 * MiB;
constexpr int RING_BYTES = 131072, HALO_OFF = RING_BYTES + 1024, LDS_BYTES = 147456;

__device__ __forceinline__ float wave_sum(float v) {
#pragma unroll
    for (int o = 1; o < 64; o <<= 1) v += __shfl_xor(v, o);
    return v;
}
__device__ __forceinline__ void transpose_item(const float* W, int K, int N, bf16* WT, bool upmap, LAS float* scr, int item, int lane) {
    const int nblk = N / 32, kb = item / nblk, nb = item % nblk, k0 = 64 * kb, n0 = 32 * nb;
    int d0 = n0;
    if (upmap) { const int f = n0 < DFF ? n0 : n0 - DFF; d0 = (f >> 7) * 256 + (f & 127) + (n0 < DFF ? 0 : 128); }
#pragma unroll 8
    for (int i = 0; i < 32; ++i) { const int kk = 2 * i + (lane >> 5); scr[kk * 33 + (lane & 31)] = W[(size_t)(k0 + kk) * N + n0 + (lane & 31)]; }
    LDS_WAIT(); asm volatile("" ::: "memory");
    const int c = lane & 7;
#pragma unroll
    for (int j = 0; j < 4; ++j) { const int n = (lane >> 3) + 8 * j; const LAS float* s = scr + (8 * c) * 33 + n;
        v4u o; o.x = pk2(s[0 * 33], s[1 * 33]); o.y = pk2(s[2 * 33], s[3 * 33]); o.z = pk2(s[4 * 33], s[5 * 33]); o.w = pk2(s[6 * 33], s[7 * 33]);
        *(GAS v4u*)(WT + (size_t)(d0 + n) * K + k0 + 8 * c) = o; }
    LDS_WAIT(); asm volatile("" ::: "memory");
}
__device__ __forceinline__ void norm_row_bf16(const float* xrow, const float* g, bf16* orow, int lane) {
    const f32x4* xr = (const f32x4*)xrow + lane; const f32x4* gr = (const f32x4*)g + lane;
    f32x4 v[4]; float s2 = 0.f;
#pragma unroll
    for (int j = 0; j < 4; ++j) { v[j] = xr[64 * j]; s2 += (v[j].x * v[j].x + v[j].y * v[j].y) + (v[j].z * v[j].z + v[j].w * v[j].w); }
    const float rstd = rsqrtf(wave_sum(s2) * (1.f / DM) + EPS);
    v2u* o8 = (v2u*)orow + lane;
#pragma unroll
    for (int j = 0; j < 4; ++j) { const f32x4 gg = gr[64 * j]; v2u w; w.x = pk2(v[j].x * rstd * gg.x, v[j].y * rstd * gg.y); w.y = pk2(v[j].z * rstd * gg.z, v[j].w * rstd * gg.w); o8[64 * j] = w; }
}
__device__ __forceinline__ void norm_row_f32(float* xrow, const float* g, int lane) {
    f32x4* xr = (f32x4*)xrow + lane; const f32x4* gr = (const f32x4*)g + lane;
    f32x4 v[4]; float s2 = 0.f;
#pragma unroll
    for (int j = 0; j < 4; ++j) { v[j] = xr[64 * j]; s2 += (v[j].x * v[j].x + v[j].y * v[j].y) + (v[j].z * v[j].z + v[j].w * v[j].w); }
    const float rstd = rsqrtf(wave_sum(s2) * (1.f / DM) + EPS);
#pragma unroll
    for (int j = 0; j < 4; ++j) xr[64 * j] = v[j] * rstd * gr[64 * j];
}
__device__ __forceinline__ void norm_rows4_bf16(const float* x, const float* g, bf16* o, size_t m, size_t rs, int lane) {
    f32x4 v[4][4]; float s2[4];
#pragma unroll
    for (int r = 0; r < 4; ++r) { const f32x4* xr = (const f32x4*)(x + (m + r * rs) * DM) + lane;
#pragma unroll
        for (int j = 0; j < 4; ++j) v[r][j] = xr[64 * j]; }
    const f32x4* gr = (const f32x4*)g + lane; f32x4 gg[4];
#pragma unroll
    for (int j = 0; j < 4; ++j) gg[j] = gr[64 * j];
#pragma unroll
    for (int r = 0; r < 4; ++r) { s2[r] = 0.f;
#pragma unroll
        for (int j = 0; j < 4; ++j) s2[r] += (v[r][j].x * v[r][j].x + v[r][j].y * v[r][j].y) + (v[r][j].z * v[r][j].z + v[r][j].w * v[r][j].w); }
#pragma unroll
    for (int r = 0; r < 4; ++r) { const float rstd = rsqrtf(wave_sum(s2[r]) * (1.f / DM) + EPS); v2u* o8 = (v2u*)(o + (m + r * rs) * DM) + lane;
#pragma unroll
        for (int j = 0; j < 4; ++j) { v2u w; w.x = pk2(v[r][j].x * rstd * gg[j].x, v[r][j].y * rstd * gg[j].y); w.y = pk2(v[r][j].z * rstd * gg[j].z, v[r][j].w * rstd * gg[j].w); o8[64 * j] = w; } }
}
__device__ __forceinline__ void norm_rows4_f32(float* x, const float* g, size_t m, size_t rs, int lane) {
    f32x4 v[4][4]; float s2[4];
#pragma unroll
    for (int r = 0; r < 4; ++r) { const f32x4* xr = (const f32x4*)(x + (m + r * rs) * DM) + lane;
#pragma unroll
        for (int j = 0; j < 4; ++j) v[r][j] = xr[64 * j]; }
    const f32x4* gr = (const f32x4*)g + lane; f32x4 gg[4];
#pragma unroll
    for (int j = 0; j < 4; ++j) gg[j] = gr[64 * j];
#pragma unroll
    for (int r = 0; r < 4; ++r) { s2[r] = 0.f;
#pragma unroll
        for (int j = 0; j < 4; ++j) s2[r] += (v[r][j].x * v[r][j].x + v[r][j].y * v[r][j].y) + (v[r][j].z * v[r][j].z + v[r][j].w * v[r][j].w); }
#pragma unroll
    for (int r = 0; r < 4; ++r) { const float rstd = rsqrtf(wave_sum(s2[r]) * (1.f / DM) + EPS); f32x4* xr = (f32x4*)(x + (m + r * rs) * DM) + lane;
#pragma unroll
        for (int j = 0; j < 4; ++j) xr[64 * j] = v[r][j] * rstd * gg[j]; }
}
__device__ __forceinline__ void gain_rows4_bf16(const float* x, const float* g, bf16* o, float* rss, size_t m, size_t rs, int lane) {
    f32x4 v[4][4];
#pragma unroll
    for (int r = 0; r < 4; ++r) { const f32x4* xr = (const f32x4*)(x + (m + r * rs) * DM) + lane;
#pragma unroll
        for (int j = 0; j < 4; ++j) v[r][j] = xr[64 * j]; }
    const f32x4* gr = (const f32x4*)g + lane; f32x4 gg[4];
#pragma unroll
    for (int j = 0; j < 4; ++j) gg[j] = gr[64 * j];
#pragma unroll
    for (int r = 0; r < 4; ++r) { float s2 = 0.f; v2u* o8 = (v2u*)(o + (m + r * rs) * DM) + lane;
#pragma unroll
        for (int j = 0; j < 4; ++j) { s2 += (v[r][j].x * v[r][j].x + v[r][j].y * v[r][j].y) + (v[r][j].z * v[r][j].z + v[r][j].w * v[r][j].w);
            v2u w; w.x = pk2(v[r][j].x * gg[j].x, v[r][j].y * gg[j].y); w.y = pk2(v[r][j].z * gg[j].z, v[r][j].w * gg[j].w); o8[64 * j] = w; }
        s2 = wave_sum(s2); if (lane < 16) rss[(m + r * rs) * 16 + lane] = lane == 0 ? s2 : 0.f; }
}
__device__ __forceinline__ int t5_bucket(int n) {
    if (n < 16) return n;
    int b = 15;
    b += (n >= 16) + (n >= 19) + (n >= 21) + (n >= 24) + (n >= 27) + (n >= 31) + (n >= 35) + (n >= 40) + (n >= 46) + (n >= 52) + (n >= 59) + (n >= 67) + (n >= 77) + (n >= 87) + (n >= 99) + (n >= 113);
    return b;
}
__device__ __forceinline__ int crow16(int r, int hi) { return (r & 3) + 8 * (r >> 2) + 4 * hi; }
__device__ __forceinline__ void gmlp_phase(LAS unsigned char* lds, int vcu, int G, const bf16* V, bf16* U, const float* vss, const float* gv, const float* wsl, const float* bl, int tid) {
    LAS bf16* WmS = (LAS bf16*)lds;
    LAS bf16* VnT = (LAS bf16*)(lds + 34816);
    const int lane = tid & 63, w = tid >> 6, ib = w >> 1, cb = w & 1, r32 = lane & 31, hi = lane >> 5, j = tid & 127, cq = tid >> 7;
    if (vcu >= 2048) return;
    v4u vraw[4]; f32x4 pa, pb, pc, pd; unsigned short ur0[16], ur1[16];
#define GM_LOAD(UU) do { const int m0_ = ((UU) >> 3) * 128, g_ = (UU) & 7; const bf16* src_ = V + (size_t)(m0_ + j) * 1024 + g_ * 128 + cq * 32; \
        _Pragma("unroll") for (int q = 0; q < 4; ++q) vraw[q] = *(const v4u*)(src_ + q * 8); \
        const f32x4* pp_ = (const f32x4*)(vss + (size_t)(m0_ + j) * 16); pa = pp_[0]; pb = pp_[1]; pc = pp_[2]; pd = pp_[3]; \
        _Pragma("unroll") for (int r = 0; r < 16; ++r) { const bf16* up_ = U + (size_t)(m0_ + 32 * ib + crow16(r, hi)) * 1024 + g_ * 128 + 64 * cb + r32; ur0[r] = up_[0]; ur1[r] = up_[32]; } } while (0)
    GM_LOAD(vcu);
    int g_cur = -1; f32x4 gq[8]; float bi[16];
    for (int u = vcu; u < 2048; u += G) {
        const int m0 = (u >> 3) * 128, g = u & 7;
        if (g != g_cur) {
            g_cur = g; const float* wsg = wsl + g * 128 * 128; const float* gp = gv + g * 128 + cq * 32;
#pragma unroll
            for (int k = 0; k < 8; ++k) { const int p = tid + 512 * k, i = p >> 5, j4 = (p & 31) * 4; f32x4 x = *(const f32x4*)(wsg + i * 128 + j4);
                if (j4 + 0 > i) x.x = 0.f; if (j4 + 1 > i) x.y = 0.f; if (j4 + 2 > i) x.z = 0.f; if (j4 + 3 > i) x.w = 0.f;
                v2u o; o.x = pk2(x.x, x.y); o.y = pk2(x.z, x.w); *(LAS v2u*)(WmS + i * 136 + j4) = o; }
#pragma unroll
            for (int q = 0; q < 8; ++q) gq[q] = *(const f32x4*)(gp + q * 4);
#pragma unroll
            for (int r = 0; r < 16; ++r) bi[r] = bl[g * 128 + 32 * ib + crow16(r, hi)];
        }
        { const float s = ((pa.x + pa.y) + (pa.z + pa.w)) + ((pb.x + pb.y) + (pb.z + pb.w)) + ((pc.x + pc.y) + (pc.z + pc.w)) + ((pd.x + pd.y) + (pd.z + pd.w));
          const float r = rsqrtf(s * (1.f / 1024.f) + EPS);
#pragma unroll
          for (int q = 0; q < 4; ++q) { const v4u raw = vraw[q]; const f32x4 g0 = gq[2 * q], g1 = gq[2 * q + 1];
              LAS bf16* d = VnT + (cq * 32 + q * 8) * 136 + j;
              d[0 * 136] = (bf16)f2bf(bflo(raw.x) * r * g0.x); d[1 * 136] = (bf16)f2bf(bfhi(raw.x) * r * g0.y); d[2 * 136] = (bf16)f2bf(bflo(raw.y) * r * g0.z); d[3 * 136] = (bf16)f2bf(bfhi(raw.y) * r * g0.w);
              d[4 * 136] = (bf16)f2bf(bflo(raw.z) * r * g1.x); d[5 * 136] = (bf16)f2bf(bfhi(raw.z) * r * g1.y); d[6 * 136] = (bf16)f2bf(bflo(raw.w) * r * g1.z); d[7 * 136] = (bf16)f2bf(bfhi(raw.w) * r * g1.w); } }
        unsigned short uc0[16], uc1[16];
#pragma unroll
        for (int r = 0; r < 16; ++r) { uc0[r] = ur0[r]; uc1[r] = ur1[r]; }
        __syncthreads();
        if (u + G < 2048) GM_LOAD(u + G);
        f32x16 acc0 = {}, acc1 = {};
        const int nks = 2 * (ib + 1);
        for (int ks = 0; ks < nks; ++ks) {
            const bf16x8 a = *(const LAS bf16x8*)(WmS + (32 * ib + r32) * 136 + 16 * ks + 8 * hi);
            const bf16x8 b0 = *(const LAS bf16x8*)(VnT + (64 * cb + r32) * 136 + 16 * ks + 8 * hi);
            const bf16x8 b1 = *(const LAS bf16x8*)(VnT + (64 * cb + 32 + r32) * 136 + 16 * ks + 8 * hi);
            acc0 = __builtin_amdgcn_mfma_f32_32x32x16_bf16(a, b0, acc0, 0, 0, 0);
            acc1 = __builtin_amdgcn_mfma_f32_32x32x16_bf16(a, b1, acc1, 0, 0, 0);
        }
#pragma unroll
        for (int r = 0; r < 16; ++r) { const int i = 32 * ib + crow16(r, hi);
            bf16* up = U + (size_t)(m0 + i) * 1024 + g * 128 + 64 * cb + r32;
            const float u0 = __uint_as_float((unsigned)uc0[r] << 16), u1 = __uint_as_float((unsigned)uc1[r] << 16);
            up[0] = (bf16)f2bf(u0 * (acc0[r] + bi[r])); up[32] = (bf16)f2bf(u1 * (acc1[r] + bi[r])); }
        __syncthreads();
    }
#undef GM_LOAD
}
constexpr int AT_KS = 0, AT_VT = 2 * 64 * 72 * 2, AT_BUF = AT_VT + 128 * 72 * 2  , AT_TAB = 2 * AT_BUF, AT_QS = AT_TAB + 1024, AT_LDS = AT_QS + 65536;
static_assert(AT_LDS <= 147456, "attention LDS");
__device__ __forceinline__ void dattn_unit(LAS unsigned char* lds, int b, int h, int qb, const bf16* Q, const bf16* K, const bf16* V, bf16* YB, float lam, const float* subg, float oml, int tid) {
    tid = mk_tid();
    const int lane = tid & 63, w = __builtin_amdgcn_readfirstlane(tid >> 6), ql = lane & 31, hi = lane >> 5;
    const LAS float* tab = (const LAS float*)(lds + AT_TAB);
    const size_t rowb = (size_t)b * SEQ;
    const int qmin = qb * 256 + w * 32, q = qmin + ql, qmax = qmin + 31;
    LAS bf16x8* qs = (LAS bf16x8*)(lds + AT_QS) + w * 512 + lane;
#pragma unroll
    for (int mp = 0; mp < 2; ++mp)
#pragma unroll
        for (int ks = 0; ks < 4; ++ks) qs[(mp * 4 + ks) * 64] = *(const bf16x8*)(Q + (rowb + q) * 1024 + h * 128 + mp * 64 + ks * 16 + hi * 8);
    f32x16 o[2][4];
#pragma unroll
    for (int mp = 0; mp < 2; ++mp)
#pragma unroll
        for (int cb = 0; cb < 4; ++cb) o[mp][cb] = f32x16{};
    float mref[2] = {0.f, 0.f}, lsum[2] = {0.f, 0.f};
    const int NT = 4 * qb + 4;
    const bf16* kg = K + (rowb + (tid >> 3)) * 1024 + h * 128 + (tid & 7) * 8;
    const bf16* vg = V + (rowb + (tid & 63)) * 1024 + h * 128 + (tid >> 6) * 16;
    v4u kr0 = *(const v4u*)(kg), kr1 = *(const v4u*)(kg + 64), vr0 = *(const v4u*)(vg), vr1 = *(const v4u*)(vg + 8);
#define AT_STAGE(BUF) do { LAS bf16* Ks_ = (LAS bf16*)(lds + (BUF) * AT_BUF + AT_KS); LAS bf16* Vt_ = (LAS bf16*)(lds + (BUF) * AT_BUF + AT_VT); \
        *(LAS v4u*)(Ks_ + (tid >> 3) * 72 + (tid & 7) * 8) = kr0; *(LAS v4u*)(Ks_ + 64 * 72 + (tid >> 3) * 72 + (tid & 7) * 8) = kr1; \
        LAS bf16* d = Vt_ + ((tid >> 6) * 16) * 72 + (tid & 63); \
        d[0 * 72] = (bf16)(vr0.x & 0xffffu); d[1 * 72] = (bf16)(vr0.x >> 16); d[2 * 72] = (bf16)(vr0.y & 0xffffu); d[3 * 72] = (bf16)(vr0.y >> 16); \
        d[4 * 72] = (bf16)(vr0.z & 0xffffu); d[5 * 72] = (bf16)(vr0.z >> 16); d[6 * 72] = (bf16)(vr0.w & 0xffffu); d[7 * 72] = (bf16)(vr0.w >> 16); \
        d[8 * 72] = (bf16)(vr1.x & 0xffffu); d[9 * 72] = (bf16)(vr1.x >> 16); d[10 * 72] = (bf16)(vr1.y & 0xffffu); d[11 * 72] = (bf16)(vr1.y >> 16); \
        d[12 * 72] = (bf16)(vr1.z & 0xffffu); d[13 * 72] = (bf16)(vr1.z >> 16); d[14 * 72] = (bf16)(vr1.w & 0xffffu); d[15 * 72] = (bf16)(vr1.w >> 16); } while (0)
    AT_STAGE(0);
    __syncthreads();
    for (int t = 0; t < NT; ++t) {
        if (t + 1 < NT) { const size_t adv = (size_t)(t + 1) * 64 * 1024; kr0 = *(const v4u*)(kg + adv); kr1 = *(const v4u*)(kg + adv + 64); vr0 = *(const v4u*)(vg + adv); vr1 = *(const v4u*)(vg + adv + 8); }
        const LAS bf16* Ks = (const LAS bf16*)(lds + (t & 1) * AT_BUF + AT_KS); const LAS bf16* Vt = (const LAS bf16*)(lds + (t & 1) * AT_BUF + AT_VT);
        const int kvbase = t * 64;
        if (kvbase <= qmax) {
#define AT_SOFTMAX(S, MP, PA, PB) do { \
            float ps = 0.f; \
            _Pragma("unroll") for (int r = 0; r < 16; ++r) { S[r] = __builtin_amdgcn_exp2f(S[r]); ps += S[r]; } \
            lsum[MP] += ps; \
            trig[MP] = __any(ps > 256.0f);     \
            if (trig[MP]) { float pm_ = fmaxf(fmaxf(fmaxf(S[0], S[1]), fmaxf(S[2], S[3])), fmaxf(fmaxf(S[4], S[5]), fmaxf(S[6], S[7]))); \
                pm_ = fmaxf(pm_, fmaxf(fmaxf(fmaxf(S[8], S[9]), fmaxf(S[10], S[11])), fmaxf(fmaxf(S[12], S[13]), fmaxf(S[14], S[15])))); \
                auto rr_ = __builtin_amdgcn_permlane32_swap(__float_as_uint(pm_), __float_as_uint(pm_), false, false); pmx[MP] = fmaxf(__uint_as_float(rr_[0]), __uint_as_float(rr_[1])); } \
            v4u pw0, pw1; \
            pw0.x = pg8::cvt_pk_bf16(S[0], S[1]); pw0.y = pg8::cvt_pk_bf16(S[2], S[3]); pw0.z = pg8::cvt_pk_bf16(S[4], S[5]); pw0.w = pg8::cvt_pk_bf16(S[6], S[7]); \
            pw1.x = pg8::cvt_pk_bf16(S[8], S[9]); pw1.y = pg8::cvt_pk_bf16(S[10], S[11]); pw1.z = pg8::cvt_pk_bf16(S[12], S[13]); pw1.w = pg8::cvt_pk_bf16(S[14], S[15]); \
            PA = __builtin_bit_cast(bf16x8, pw0); PB = __builtin_bit_cast(bf16x8, pw1); } while (0)
#define AT_RAISE(MP) do { if (trig[MP]) { const float dl = fmaxf(__builtin_amdgcn_logf(pmx[MP]), 0.f), al = __builtin_amdgcn_exp2f(-dl); mref[MP] += dl; lsum[MP] *= al; \
                _Pragma("unroll") for (int cb = 0; cb < 4; ++cb) o[MP][cb] = o[MP][cb] * al; } } while (0)
#pragma unroll
        for (int sub = 0; sub < 2; ++sub) {
            if (kvbase + 32 * sub > qmax) continue;
            const bool need_bm = kvbase + 32 * sub + 31 + 113 > qmin;
            LAS bf16x8* qsp = qs; asm volatile("" : "+v"(qsp));
            f32x16 s0, s1;
#pragma unroll
            for (int r = 0; r < 16; ++r) { s0[r] = -mref[0]; s1[r] = -mref[1]; }
#pragma unroll
            for (int ks = 0; ks < 4; ++ks) { const LAS bf16* kp = Ks + (32 * sub + ql) * 72 + ks * 16 + hi * 8;
                s0 = __builtin_amdgcn_mfma_f32_32x32x16_bf16(*(const LAS bf16x8*)kp, qsp[ks * 64], s0, 0, 0, 0);
                s1 = __builtin_amdgcn_mfma_f32_32x32x16_bf16(*(const LAS bf16x8*)(kp + 64 * 72), qsp[(4 + ks) * 64], s1, 0, 0, 0); }
            if (need_bm) { const LAS float* gb = tab + (159 - (q - (kvbase + 32 * sub + 4 * hi)));
#pragma unroll
                for (int r = 0; r < 16; ++r) { const float bv = gb[(r & 3) + 8 * (r >> 2)]; s0[r] += bv; s1[r] += bv; } }
            bf16x8 pA0, pB0, pA1, pB1; bool trig[2]; float pmx[2] = {1.f, 1.f};
            AT_SOFTMAX(s0, 0, pA0, pB0);
            AT_SOFTMAX(s1, 1, pA1, pB1);
#pragma unroll
            for (int cb = 0; cb < 4; ++cb) { const LAS bf16* vp = Vt + (32 * cb + ql) * 72 + 32 * sub + 4 * hi;
                const v2u a0 = *(const LAS v2u*)(vp), a1 = *(const LAS v2u*)(vp + 8), a2 = *(const LAS v2u*)(vp + 16), a3 = *(const LAS v2u*)(vp + 24);
                const v4u f0 = {a0.x, a0.y, a1.x, a1.y}, f1 = {a2.x, a2.y, a3.x, a3.y};
                o[0][cb] = __builtin_amdgcn_mfma_f32_32x32x16_bf16(__builtin_bit_cast(bf16x8, f0), pA0, o[0][cb], 0, 0, 0);
                o[1][cb] = __builtin_amdgcn_mfma_f32_32x32x16_bf16(__builtin_bit_cast(bf16x8, f0), pA1, o[1][cb], 0, 0, 0);
                o[0][cb] = __builtin_amdgcn_mfma_f32_32x32x16_bf16(__builtin_bit_cast(bf16x8, f1), pB0, o[0][cb], 0, 0, 0);
                o[1][cb] = __builtin_amdgcn_mfma_f32_32x32x16_bf16(__builtin_bit_cast(bf16x8, f1), pB1, o[1][cb], 0, 0, 0); }
            AT_RAISE(0); AT_RAISE(1);
        }
#undef AT_SOFTMAX
#undef AT_RAISE
        }
        if (t + 1 < NT) AT_STAGE((t + 1) & 1);
        __syncthreads();
    }
#undef AT_STAGE
    const float l1 = lsum[0] + __shfl_xor(lsum[0], 32), l2 = lsum[1] + __shfl_xor(lsum[1], 32);
    const float i1 = 1.0f / l1, i2 = lam / l2; float ss = 0.f;
#pragma unroll
    for (int cb = 0; cb < 4; ++cb)
#pragma unroll
        for (int r = 0; r < 16; ++r) { const float y = o[0][cb][r] * i1 - o[1][cb][r] * i2; o[0][cb][r] = y; ss += y * y; }
    ss += __shfl_xor(ss, 32);
    const float rstd = rsqrtf(ss * (1.f / 128.f) + EPS) * oml;
    bf16* op = YB + (rowb + q) * 1024 + h * 128;
#pragma unroll
    for (int cb = 0; cb < 4; ++cb)
#pragma unroll
        for (int rg = 0; rg < 4; ++rg) { const int c = 32 * cb + 8 * rg + 4 * hi; const f32x4 g = *(const f32x4*)(subg + c);
            v2u wv; wv.x = pk2(o[0][cb][4 * rg + 0] * rstd * g.x, o[0][cb][4 * rg + 1] * rstd * g.y); wv.y = pk2(o[0][cb][4 * rg + 2] * rstd * g.z, o[0][cb][4 * rg + 3] * rstd * g.w);
            *(v2u*)(op + c) = wv; }
}
__device__ __forceinline__ void attn_super(LAS unsigned char* lds, int su, const bf16* Q, const bf16* K, const bf16* VA, bf16* YB, const float* tabg, float lam, const float* subg, float oml, int tid) {
    const int bh = su >> 2, b = bh >> 3, h = bh & 7, s = su & 3;
    __syncthreads();
    if (tid < 192) { const int rel = 159 - tid; ((LAS float*)(lds + AT_TAB))[tid] = rel < 0 ? -1e30f : (rel < 128 ? tabg[h * 132 + rel] : 0.f); }
    __syncthreads();
    for (int qi = 0; qi < 4; ++qi) {
        const int qb = (qi == 0) ? s : (qi == 1) ? 7 - s : (qi == 2) ? 8 + s : 15 - s;
        dattn_unit(lds, b, h, qb, Q, K, VA, YB, lam, subg, oml, tid);
    }
    __syncthreads();
}

#define RLX_AGENT __ATOMIC_RELAXED, __HIP_MEMORY_SCOPE_AGENT
#define XB_TMO      128
#define XB_XCNT(j)  (256  + 64 * (j))
#define XB_XSUB(j)  (1280 + 64 * (j))
#define XB_XGEN(j)  (2304 + 64 * (j))
#define XB_TOP      3328
#define XB_TOPGEN   3392
#define XCD_BAR_WORDS 3456
#define XB_SPIN_CAP (1u << 18)

__device__ __forceinline__ unsigned xb_ld(unsigned* p)              { return __hip_atomic_load(p, __ATOMIC_RELAXED, __HIP_MEMORY_SCOPE_AGENT); }
__device__ __forceinline__ unsigned xb_add(unsigned* p, unsigned v) { return __hip_atomic_fetch_add(p, v, __ATOMIC_RELAXED, __HIP_MEMORY_SCOPE_AGENT); }
__device__ __forceinline__ unsigned xb_xcc_id() { return (unsigned)__builtin_amdgcn_s_getreg((3 << 11) | 20) & 0xFu; }
#define XB_SPIN(cond, bar) do { unsigned _sp = 0; while (cond) { __builtin_amdgcn_s_sleep(1); \
    if ((++_sp & 255u) == 0u) { if (xb_ld(&(bar)[XB_TMO])) break; if (_sp > XB_SPIN_CAP) { atomicAdd(&(bar)[XB_TMO], 1u); break; } } } } while (0)

struct XcdBarrier {
    unsigned* bar; unsigned x;
    volatile LAS unsigned* st;
};

__device__ __forceinline__ XcdBarrier xcd_barrier_post(unsigned* bar, volatile LAS unsigned* st) {
    XcdBarrier b; b.bar = bar; b.x = xb_xcc_id(); b.st = st;
    if (threadIdx.x == 0) (void)xb_add(&bar[XB_XCNT(b.x)], 1u);
    return b;
}
__device__ __forceinline__ void xcd_barrier_complete(unsigned* bar, unsigned x, unsigned& nloc, unsigned& nx) {
    const unsigned G = gridDim.x * gridDim.y * gridDim.z;
    unsigned sum, cnt, mine, sp = 0u;
    for (;;) {
        sum = 0u; cnt = 0u; mine = 0u;
#pragma unroll
        for (unsigned j = 0; j < 16; ++j) { const unsigned c = xb_ld(&bar[XB_XCNT(j)]); sum += c; cnt += (c > 0u) ? 1u : 0u; mine = (j == x) ? c : mine; }
        if (sum == G) break;
        __builtin_amdgcn_s_sleep(1);
        if ((++sp & 255u) == 0u) { if (xb_ld(&bar[XB_TMO])) break; if (sp > XB_SPIN_CAP) { atomicAdd(&bar[XB_TMO], 1u); break; } }
    }
    nloc = mine > 0u ? mine : 1u; nx = cnt > 0u ? cnt : 1u;
}

__device__ __forceinline__ void xcd_barrier(const XcdBarrier& b) {
    asm volatile("s_waitcnt vmcnt(0)" ::: "memory");
    __syncthreads();
    if (threadIdx.x == 0) {
        unsigned* bar = b.bar;
        __builtin_amdgcn_s_waitcnt(0);
        unsigned nloc = b.st[0], nx = b.st[1];
        if (nloc == 0u) { xcd_barrier_complete(bar, b.x, nloc, nx); b.st[0] = nloc; b.st[1] = nx; }
        const unsigned old = xb_add(&bar[XB_XSUB(b.x)], 1u);
        const unsigned gen = old / nloc;
        if (old + 1u == (gen + 1u) * nloc) {
            __builtin_amdgcn_fence(__ATOMIC_RELEASE, "agent");
            asm volatile("s_waitcnt vmcnt(0)" ::: "memory");
            const unsigned og = xb_add(&bar[XB_TOP], 1u);
            const unsigned tg = og / nx;
            if (og + 1u == (tg + 1u) * nx) xb_add(&bar[XB_TOPGEN], 1u);
            else XB_SPIN(xb_ld(&bar[XB_TOPGEN]) == tg, bar);
            __builtin_amdgcn_fence(__ATOMIC_ACQUIRE, "agent");
            xb_add(&bar[XB_XGEN(b.x)], 1u);
            asm volatile("s_waitcnt vmcnt(0)" ::: "memory");
        } else {
            XB_SPIN(xb_ld(&bar[XB_XGEN(b.x)]) == gen, bar);
            __builtin_amdgcn_fence(__ATOMIC_ACQUIRE, "agent");
            asm volatile("s_waitcnt vmcnt(0)" ::: "memory");
        }
    }
    __syncthreads();
}

constexpr size_t WS_BAR = 32768;
constexpr int BAR_LDS_OFF = 147456 - 64;
struct Args { const float* in[22]; float* out; unsigned char* ws; int ph_lo, ph_hi; };
constexpr int N_PHASES = 2 + 7 * DEPTH;
__global__ void __launch_bounds__(NWAVES * 64, 2) mk_fwd(Args args) {
    extern __shared__ __attribute__((aligned(16))) unsigned char lds_raw[];
    LAS unsigned char* lds = (LAS unsigned char*)lds_raw;
    typedef const __attribute__((address_space(4))) Args* kargs_t;
    if (threadIdx.x < 16) ((LAS unsigned*)(lds + BAR_LDS_OFF))[threadIdx.x] = 0u;
    __syncthreads();
    const XcdBarrier bar = xcd_barrier_post((unsigned*)(args.ws + WS_BAR), (volatile LAS unsigned*)(lds + BAR_LDS_OFF));
    for (int ph = args.ph_lo; ph < args.ph_hi; ++ph) {
        const int tid = mk_tid(), lane = tid & 63, wave = __builtin_amdgcn_readfirstlane(tid >> 6);
        int G = gridDim.x, bx = blockIdx.x; asm volatile("" : "+s"(G), "+s"(bx));
        const int vcu = (G % 8 == 0) ? (bx % 8) * (G / 8) + bx / 8 : bx;
        const int gw = vcu * NWAVES + wave, NGW = G * NWAVES;
        unsigned long long kp_ = (unsigned long long)__builtin_amdgcn_kernarg_segment_ptr(); asm volatile("" : "+s"(kp_));
        const kargs_t ap = (kargs_t)kp_;
        unsigned char* ws = ap->ws;
        const float* x_in = ap->in[0]; float* xo = ap->out;
        bf16* HB = (bf16*)(ws + WS_HB); bf16* VAb = (bf16*)(ws + WS_VA); bf16* Ub = (bf16*)(ws + WS_U); bf16* Vb = (bf16*)(ws + WS_V); bf16* Qb = (bf16*)(ws + WS_Q); bf16* Kb = (bf16*)(ws + WS_K);
        bf16* TMP = (bf16*)(ws + WS_TMP); bf16* ACT = (bf16*)(ws + WS_ACT);
        float* lamw = (float*)(ws + WS_LAM); float* tabw = (float*)(ws + WS_TAB); float* vss = (float*)(ws + WS_VSS);
        if (ph == 0) {
            LAS float* scr = (LAS float*)(lds + wave * 16384);
            constexpr int I_IN = 16 * (NIN / 32), I_G = 16 * (NGATE / 32), I_S = 16 * 32, I_UP = 16 * (NUP / 32), I_DN = (DFF / 64) * 32, I_L = I_IN + I_G + 3 * I_S + I_UP + I_DN;
            for (int it = gw; it < DEPTH * I_L; it += NGW) {
                const int l = it / I_L; int r = it - l * I_L; bf16* wl = (bf16*)(ws + WS_W + (size_t)l * WL_STRIDE);
                if (r < I_IN) { transpose_item(ap->in[2] + (size_t)l * DM * NIN, DM, NIN, (bf16*)((unsigned char*)wl + WO_IN), false, scr, r, lane); continue; } r -= I_IN;
                if (r < I_G) { transpose_item(ap->in[3] + (size_t)l * DM * NGATE, DM, NGATE, (bf16*)((unsigned char*)wl + WO_G), false, scr, r, lane); continue; } r -= I_G;
                if (r < I_S) { transpose_item(ap->in[13] + (size_t)l * DM * DM, DM, DM, (bf16*)((unsigned char*)wl + WO_A), false, scr, r, lane); continue; } r -= I_S;
                if (r < I_S) { transpose_item(ap->in[14] + (size_t)l * DM * DM, DM, DM, (bf16*)((unsigned char*)wl + WO_B), false, scr, r, lane); continue; } r -= I_S;
                if (r < I_S) { transpose_item(ap->in[15] + (size_t)l * DM * DM, DM, DM, (bf16*)((unsigned char*)wl + WO_O), false, scr, r, lane); continue; } r -= I_S;
                if (r < I_UP) { transpose_item(ap->in[17] + (size_t)l * DM * NUP, DM, NUP, (bf16*)((unsigned char*)wl + WO_UP), true, scr, r, lane); continue; } r -= I_UP;
                transpose_item(ap->in[20] + (size_t)l * DFF * DM, DFF, DM, (bf16*)((unsigned char*)wl + WO_DN), false, scr, r, lane);
            }
            for (int m = gw; m < M; m += 4 * NGW) gain_rows4_bf16(x_in, ap->in[1], HB, (float*)(ws + WS_RSS), (size_t)m, (size_t)NGW, lane);
            if (bx == 0) {
                if (wave < DEPTH) { const int l = wave; const float a = wave_sum(ap->in[7][l * 64 + lane] * ap->in[8][l * 64 + lane]), b = wave_sum(ap->in[9][l * 64 + lane] * ap->in[10][l * 64 + lane]);
                    const float lam_init = 0.8f - 0.6f * expf(-0.3f * (float)l);
                    if (lane == 0) lamw[l] = expf(a) - expf(b) + lam_init; }
                for (int e = tid; e < NHEAD * 132; e += NWAVES * 64) { const int h = e / 132, rel = e - h * 132; const float* rb = ap->in[12];
                    tabw[e] = rel < 128 ? (rb[t5_bucket(rel) * NHEAD + h] - rb[31 * NHEAD + h]) * 1.4426950408889634f : 0.f; }
            }
        } else if (ph == N_PHASES - 1) {
            if (M % (4 * NGW) == 0) { for (int m = gw; m < M; m += 4 * NGW) norm_rows4_f32(xo, ap->in[21], (size_t)m, (size_t)NGW, lane); }
            else for (int m = gw; m < M; m += NGW) norm_row_f32(xo + (size_t)m * DM, ap->in[21], lane);
        } else {
            const int l = (ph - 1) / 7, k = (ph - 1) % 7;
            unsigned char* wl = ws + WS_W + (size_t)l * WL_STRIDE; float* rss = (float*)(ws + WS_RSS);
            if (k == 0) {
                pg8::Gemm g{HB, (const bf16*)(wl + WO_IN), M, NIN, DM}; pg8::StaticOrder S; S.init(M / 256, NIN / 256, G, bx);
                pg8::EpiIn E{Ub, (size_t)(WS_V - WS_U) / 2, VAb, vss, QSCALE, rss};
                pg8::gemm_phase<pg8::EpiIn, pg8::StaticOrder, true, true>(lds, g, S, E);
            } else if (k == 1) {
                const float* gv = ap->in[4] + l * DM; const float* wsl = ap->in[5] + (size_t)l * 8 * 128 * 128; const float* bl = ap->in[6] + l * 8 * 128;
                gmlp_phase(lds, vcu, G, Vb, Ub, vss, gv, wsl, bl, tid);
                const float lam = lamw[l]; const float oml = 1.0f - (0.8f - 0.6f * expf(-0.3f * (float)l));
                for (int su = vcu; su < 256; su += G) attn_super(lds, su, Qb, Kb, VAb, Qb, tabw, lam, ap->in[11] + l * 128, oml, tid);
            } else if (k == 2) {
                pg8::Gemm g{HB, (const bf16*)(wl + WO_G), M, NGATE, DM}; pg8::StaticOrder S; S.init(M / 256, NGATE / 256, G, bx);
                pg8::EpiGate E{Vb, Kb, rss};
                pg8::gemm_phase<pg8::EpiGate, pg8::StaticOrder, true, true>(lds, g, S, E);
            } else if (k == 3) {
                { pg8::Gemm g{Ub, (const bf16*)(wl + WO_A), M, DM, DM}; pg8::StaticOrder S; S.init(M / 256, DM / 256, G, bx);
                  pg8::EpiMerge<0> E{Vb, TMP, nullptr};
                  pg8::gemm_phase<pg8::EpiMerge<0>, pg8::StaticOrder, true, true>(lds, g, S, E); }
                { pg8::Gemm g{Qb, (const bf16*)(wl + WO_B), M, DM, DM}; pg8::StaticOrder S; S.init(M / 256, DM / 256, G, bx);
                  pg8::EpiMerge<1> E{Kb, TMP, VAb};
                  pg8::gemm_phase<pg8::EpiMerge<1>, pg8::StaticOrder, true, true>(lds, g, S, E); }
            } else if (k == 4 || k == 6) {
                pg8::Gemm g{k == 4 ? VAb : ACT, (const bf16*)(wl + (k == 4 ? WO_O : WO_DN)), M, DM, k == 4 ? DM : DFF}; pg8::StaticOrder S; S.init(M / 256, DM / 256, G, bx);
                const bool leave = (k == 4) || (l + 1 < DEPTH);
                pg8::EpiRes E{(l == 0 && k == 4) ? x_in : xo, xo, leave ? HB : nullptr, k == 4 ? ap->in[16] + l * DM : ap->in[1] + (l + 1 < DEPTH ? l + 1 : l) * DM, rss};
                pg8::gemm_phase<pg8::EpiRes, pg8::StaticOrder, true, true>(lds, g, S, E);
            } else {
                pg8::Gemm g{HB, (const bf16*)(wl + WO_UP), M, NUP, DM}; pg8::StaticOrder S; S.init(BATCH * 17, NUP / 256, G, bx, 1);
                pg8::EpiUp E{ACT, ap->in[18] + (size_t)l * 3 * DFF, ap->in[19] + (size_t)l * DFF, (LAS float*)(lds + HALO_OFF), rss};
                pg8::gemm_phase<pg8::EpiUp, pg8::StaticOrder, true, true>(lds, g, S, E);
            }
        }
        if (ph + 1 < args.ph_hi) { if (ph < 0) cg::this_grid().sync(); else xcd_barrier(bar); }
    }
}

extern "C" void kernel_launch(void* const* d_in, const int* in_sizes, int n_in, void* d_out, int out_size, void* d_ws, size_t ws_size, hipStream_t stream) {
    static int grid = 0;
    if (grid == 0) {
        if (n_in != 22 || out_size != M * DM || ws_size < WS_END) { fprintf(stderr, "kernel_launch: unexpected shapes (n_in %d out %d ws %zu)\n", n_in, out_size, ws_size); grid = -1; return; }
        int dev = 0, cus = 0, per_cu = 0;
        if (hipGetDevice(&dev) != hipSuccess || hipDeviceGetAttribute(&cus, hipDeviceAttributeMultiprocessorCount, dev) != hipSuccess) { grid = -1; return; }
        if (hipFuncSetAttribute((const void*)mk_fwd, hipFuncAttributeMaxDynamicSharedMemorySize, LDS_BYTES) != hipSuccess) { fprintf(stderr, "kernel_launch: hipFuncSetAttribute failed\n"); grid = -1; return; }
        if (hipOccupancyMaxActiveBlocksPerMultiprocessor(&per_cu, (const void*)mk_fwd, NWAVES * 64, LDS_BYTES) != hipSuccess || per_cu < 1) { fprintf(stderr, "kernel_launch: occupancy query gave %d\n", per_cu); per_cu = 1; }
        (void)hipGetLastError();
        grid = cus;
    }
    if (grid < 0) return;
    if (hipMemsetAsync((char*)d_ws + WS_BAR, 0, 16384, stream) != hipSuccess) { fprintf(stderr, "kernel_launch: hipMemsetAsync failed\n"); return; }
    Args a{};
    for (int i = 0; i < 22; ++i) a.in[i] = (const float*)d_in[i];
    a.out = (float*)d_out; a.ws = (unsigned char*)d_ws;
#if MK_SINGLE
    a.ph_lo = 0; a.ph_hi = N_PHASES;
    void* kargs[] = {&a};
    const hipError_t e = hipLaunchCooperativeKernel((const void*)mk_fwd, dim3(grid), dim3(NWAVES * 64), kargs, LDS_BYTES, stream);
    if (e != hipSuccess) fprintf(stderr, "kernel_launch: cooperative launch failed: %s (grid %d)\n", hipGetErrorString(e), grid);
#else
    for (int p = 0; p < N_PHASES; ++p) { a.ph_lo = p; a.ph_hi = p + 1; hipLaunchKernelGGL(mk_fwd, dim3(grid), dim3(NWAVES * 64), LDS_BYTES, stream, a); }
#endif
}
```
